# Optimizing an MI355X kernel written in HIP

```python
import math
import jax, jax.numpy as jnp
from jax import lax
import numpy as np

D_MODEL = 1024
BATCH = 16
SEQ = 4096
DEPTH = 1

GMLP_WIDTH = 512
GMLP_GROUPS = 8
GMLP_HEAD = GMLP_WIDTH // GMLP_GROUPS
CHUNK = 128
S5_WIDTH = 256
S5_GROUP_CH = 16
S5_GROUPS = S5_WIDTH // S5_GROUP_CH
S5_STATE = 64
P_TOTAL = 2 * GMLP_WIDTH + S5_WIDTH + 2 * D_MODEL
N_EXPERTS = 16
CAPACITY_FACTOR = 2
EXPERT_FF = 2048
EPS = 1e-6

kernel_name = "hybrid_gmlp_s5_expert_choice_encoder_block"


def rms_norm(x, g):
    xf = x.astype(jnp.float32)
    r = lax.rsqrt(jnp.mean(xf * xf, axis=-1, keepdims=True) + EPS)
    return (xf * r * g.astype(jnp.float32)).astype(x.dtype)


def gmlp_spatial_gating(u, v, ln_g, ln_b, w_s, b_s):
    bn, seq, _ = u.shape
    vf = v.astype(jnp.float32)
    mu = jnp.mean(vf, axis=-1, keepdims=True)
    var = jnp.mean(jnp.square(vf - mu), axis=-1, keepdims=True)
    vn = (vf - mu) * lax.rsqrt(var + EPS) * ln_g.astype(jnp.float32) + ln_b.astype(jnp.float32)
    vc = vn.reshape(bn, seq // CHUNK, CHUNK, GMLP_GROUPS, GMLP_HEAD)
    z = jnp.einsum('gts,bnsgc->bntgc', w_s.astype(jnp.float32), vc) \
        + jnp.transpose(b_s.astype(jnp.float32))[:, :, None]
    return u * z.reshape(bn, seq, GMLP_WIDTH).astype(u.dtype)


def _ssm_combine(e1, e2):
    a1, b1 = e1
    a2, b2 = e2
    return a1 * a2, a2 * b1 + b2


def s5_direction(u, lam_re, lam_im, log_dt, b_re, b_im, c_re, c_im, reverse):
    f32 = jnp.float32
    lam = lax.complex(lam_re.astype(f32), lam_im.astype(f32))
    dt = jnp.exp(log_dt.astype(f32))[:, None]
    lam_bar = jnp.exp(lam * dt)
    bmat = lax.complex(b_re.astype(f32), b_im.astype(f32))
    b_bar = ((lam_bar - 1.0) / lam)[:, :, None] * bmat
    bu = jnp.einsum('gph,blgh->blgp', b_bar, u.astype(jnp.complex64))
    a = jnp.broadcast_to(lam_bar, bu.shape)
    _, states = lax.associative_scan(_ssm_combine, (a, bu), axis=1, reverse=reverse)
    cmat = lax.complex(c_re.astype(f32), c_im.astype(f32))
    return jnp.real(jnp.einsum('ghp,blgp->blgh', cmat, states))


def s5_mixer(s, lam_re, lam_im, log_dt, b_re, b_im, c_re, c_im, d_skip, w_glu, b_glu):
    bn, seq, _ = s.shape
    sf = s.astype(jnp.float32).reshape(bn, seq, S5_GROUPS, S5_GROUP_CH)
    y = (s5_direction(sf, lam_re[0], lam_im[0], log_dt[0], b_re[0], b_im[0], c_re[0], c_im[0], False)
         + s5_direction(sf, lam_re[1], lam_im[1], log_dt[1], b_re[1], b_im[1], c_re[1], c_im[1], True)
         + d_skip.astype(jnp.float32) * sf)
    y = jax.nn.gelu(y.reshape(bn, seq, S5_WIDTH), approximate=False)
    y = y * jax.nn.sigmoid(y @ w_glu.astype(jnp.float32) + b_glu.astype(jnp.float32))
    return y.astype(s.dtype)


def expert_choice_ffn(h, w_router, w_gate, w_up, w_down):
    bn, seq, dm = h.shape
    cap = CAPACITY_FACTOR * seq // N_EXPERTS
    probs = jax.nn.softmax(jnp.einsum('bld,de->ble', h, w_router).astype(jnp.float32), axis=-1)
    scores = jnp.transpose(probs, (0, 2, 1))
    gate, idx = lax.top_k(scores, cap)
    xs = jax.vmap(lambda hb, ib: hb[ib])(h, idx)
    a = jnp.einsum('becd,edf->becf', xs, w_gate)
    u = jnp.einsum('becd,edf->becf', xs, w_up)
    y = jnp.einsum('becf,efd->becd', jax.nn.silu(a) * u, w_down)
    y = (y * gate[..., None]).astype(h.dtype)
    seg = (idx + (jnp.arange(bn, dtype=jnp.int32) * seq)[:, None, None]).reshape(-1)
    out = jax.ops.segment_sum(y.reshape(-1, dm), seg, num_segments=bn * seq)
    return out.reshape(bn, seq, dm)


def setup_inputs(seed: int = 0) -> dict:
    key = jax.random.key(seed)
    ks = jax.random.split(key, 32)
    f32 = jnp.float32
    nrm = lambda k, shape, scale: (jax.random.normal(k, shape, f32) * scale)
    L_ = DEPTH
    x = jax.random.normal(ks[0], (BATCH, SEQ, D_MODEL), f32)
    norm1_g = 1.0 + nrm(ks[1], (L_, D_MODEL), 0.02)
    w_in = nrm(ks[2], (L_, D_MODEL, P_TOTAL), D_MODEL ** -0.5)
    b_gate = nrm(ks[3], (L_, 2 * D_MODEL), 0.02)
    gmlp_ln_g = 1.0 + nrm(ks[4], (L_, GMLP_WIDTH), 0.02)
    gmlp_ln_b = nrm(ks[5], (L_, GMLP_WIDTH), 0.02)
    gmlp_w_s = nrm(ks[6], (L_, GMLP_GROUPS, CHUNK, CHUNK), CHUNK ** -0.5)
    gmlp_b_s = 1.0 + nrm(ks[7], (L_, GMLP_GROUPS, CHUNK), 0.1)
    dshape = (L_, 2, S5_GROUPS, S5_STATE)
    s5_lam_re = -0.5 + nrm(ks[8], dshape, 0.01)
    n_idx = jnp.arange(S5_STATE, dtype=f32)
    s5_lam_im = jnp.pi * n_idx + nrm(ks[9], dshape, 0.01)
    s5_log_dt = jax.random.uniform(ks[10], (L_, 2, S5_GROUPS), f32,
                                   minval=math.log(0.001), maxval=math.log(0.1))
    bscale = (2.0 * S5_GROUP_CH) ** -0.5
    s5_b_re = nrm(ks[11], (L_, 2, S5_GROUPS, S5_STATE, S5_GROUP_CH), bscale)
    s5_b_im = nrm(ks[12], (L_, 2, S5_GROUPS, S5_STATE, S5_GROUP_CH), bscale)
    cscale = (2.0 * S5_STATE) ** -0.5
    s5_c_re = nrm(ks[13], (L_, 2, S5_GROUPS, S5_GROUP_CH, S5_STATE), cscale)
    s5_c_im = nrm(ks[14], (L_, 2, S5_GROUPS, S5_GROUP_CH, S5_STATE), cscale)
    s5_d = nrm(ks[15], (L_, S5_GROUPS, S5_GROUP_CH), 1.0)
    s5_w_glu = nrm(ks[16], (L_, S5_WIDTH, S5_WIDTH), S5_WIDTH ** -0.5)
    s5_b_glu = nrm(ks[17], (L_, S5_WIDTH), 0.02)
    w_up_a = nrm(ks[18], (L_, GMLP_WIDTH, D_MODEL), GMLP_WIDTH ** -0.5)
    w_up_b = nrm(ks[19], (L_, S5_WIDTH, D_MODEL), S5_WIDTH ** -0.5)
    w_out = nrm(ks[20], (L_, D_MODEL, D_MODEL), D_MODEL ** -0.5)
    norm2_g = 1.0 + nrm(ks[21], (L_, D_MODEL), 0.02)
    w_router = nrm(ks[22], (L_, D_MODEL, N_EXPERTS), D_MODEL ** -0.5)
    w_gate = nrm(ks[23], (L_, N_EXPERTS, D_MODEL, EXPERT_FF), D_MODEL ** -0.5)
    w_up = nrm(ks[24], (L_, N_EXPERTS, D_MODEL, EXPERT_FF), D_MODEL ** -0.5)
    w_down = nrm(ks[25], (L_, N_EXPERTS, EXPERT_FF, D_MODEL), EXPERT_FF ** -0.5)
    final_g = 1.0 + nrm(ks[26], (D_MODEL,), 0.02)
    return {"x": x, "norm1_g": norm1_g, "w_in": w_in, "b_gate": b_gate,
            "gmlp_ln_g": gmlp_ln_g, "gmlp_ln_b": gmlp_ln_b, "gmlp_w_s": gmlp_w_s, "gmlp_b_s": gmlp_b_s,
            "s5_lam_re": s5_lam_re, "s5_lam_im": s5_lam_im, "s5_log_dt": s5_log_dt,
            "s5_b_re": s5_b_re, "s5_b_im": s5_b_im, "s5_c_re": s5_c_re, "s5_c_im": s5_c_im,
            "s5_d": s5_d, "s5_w_glu": s5_w_glu, "s5_b_glu": s5_b_glu,
            "w_up_a": w_up_a, "w_up_b": w_up_b, "w_out": w_out, "norm2_g": norm2_g,
            "w_router": w_router, "w_gate": w_gate, "w_up": w_up, "w_down": w_down,
            "final_g": final_g}


def reference(x, norm1_g, w_in, b_gate, gmlp_ln_g, gmlp_ln_b, gmlp_w_s, gmlp_b_s,
              s5_lam_re, s5_lam_im, s5_log_dt, s5_b_re, s5_b_im, s5_c_re, s5_c_im,
              s5_d, s5_w_glu, s5_b_glu, w_up_a, w_up_b, w_out, norm2_g,
              w_router, w_gate, w_up, w_down, final_g):
    o_s5 = 2 * GMLP_WIDTH
    o_gate = o_s5 + S5_WIDTH
    for l in range(DEPTH):
        h = rms_norm(x, norm1_g[l])
        p = h @ w_in[l]
        uv = jax.nn.gelu(p[..., :o_s5], approximate=False)
        s_in = p[..., o_s5:o_gate]
        gates = jax.nn.sigmoid(p[..., o_gate:] + b_gate[l])
        g_a, g_b = gates[..., :D_MODEL], gates[..., D_MODEL:]
        br_a = gmlp_spatial_gating(uv[..., :GMLP_WIDTH], uv[..., GMLP_WIDTH:],
                                   gmlp_ln_g[l], gmlp_ln_b[l], gmlp_w_s[l], gmlp_b_s[l])
        br_b = s5_mixer(s_in, s5_lam_re[l], s5_lam_im[l], s5_log_dt[l], s5_b_re[l], s5_b_im[l],
                        s5_c_re[l], s5_c_im[l], s5_d[l], s5_w_glu[l], s5_b_glu[l])
        merged = g_a * (br_a @ w_up_a[l]) + g_b * (br_b @ w_up_b[l])
        x = x + (merged @ w_out[l]).astype(x.dtype)
        h2 = rms_norm(x, norm2_g[l])
        x = x + expert_choice_ffn(h2, w_router[l], w_gate[l], w_up[l], w_down[l]).astype(x.dtype)
    return rms_norm(x, final_g)
```

```cpp
#include <hip/hip_runtime.h>
#include <hip/hip_cooperative_groups.h>
#include <cstdio>
#include <cstdint>
namespace cg = cooperative_groups;

#ifndef DIAG_NPH
#define DIAG_NPH NPHASE
#endif
#ifndef MK_ONE_LAUNCH
#define MK_ONE_LAUNCH 0
#endif

#define GAS __attribute__((address_space(1)))
#define LAS __attribute__((address_space(3)))
typedef unsigned short bf16;
typedef short bf16x8 __attribute__((ext_vector_type(8)));
typedef float f32x4 __attribute__((ext_vector_type(4)));
typedef float f32x2 __attribute__((ext_vector_type(2)));
typedef unsigned u32x4 __attribute__((ext_vector_type(4)));
typedef unsigned u32x2 __attribute__((ext_vector_type(2)));

constexpr int NB = 16, SEQ = 4096, DM = 1024, NTOK = NB * SEQ;
constexpr int PT = 3328;
constexpr int NE = 16, CAP = 512, FF = 2048;
constexpr int TCH = 16, NCHUNK = NTOK / TCH, CPS = SEQ / TCH;
constexpr float EPS = 1e-6f;
constexpr int NWAVES = 8, NTHR = 512;

constexpr size_t MiB = 1u << 20;
constexpr size_t WS_WIN_T = 1 * MiB;
constexpr size_t WS_WS = 8 * MiB;
constexpr size_t WS_WGLU_T = 8 * MiB + 512 * 1024;
constexpr size_t WS_WUPA_T = 9 * MiB;
constexpr size_t WS_WUPB_T = 10 * MiB;
constexpr size_t WS_WOUT_T = 11 * MiB;
constexpr size_t WS_LT = 13 * MiB;
constexpr size_t WS_BCO = 14 * MiB;
constexpr size_t WS_BMAIN = 16 * MiB;
constexpr size_t WS_WGU_T = 32 * MiB;
constexpr size_t WS_WD_T = 160 * MiB;
constexpr size_t WS_H1 = 224 * MiB;
constexpr size_t WS_MERGED = 224 * MiB;
constexpr size_t WS_UV = 352 * MiB;
constexpr size_t WS_GATES = 480 * MiB;
constexpr size_t WS_HID = 224 * MiB;
constexpr size_t WS_ACOMB = 736 * MiB;
constexpr size_t WS_SLOC = 800 * MiB;
constexpr size_t WS_BRA = 864 * MiB;
constexpr size_t WS_Y = 928 * MiB;
constexpr size_t WS_BRB = 960 * MiB;
constexpr size_t WS_H2 = 736 * MiB;
constexpr size_t WS_YS = 736 * MiB;
constexpr size_t WS_PROBS = 992 * MiB;
constexpr size_t WS_IDX = 996 * MiB;
constexpr size_t WS_GATEV = 997 * MiB;
constexpr size_t WS_SEL = 998 * MiB;
constexpr size_t WS_END = 1024 * MiB;

constexpr int LDS_BYTES = 147456;

typedef __bf16 bf16x2_t __attribute__((ext_vector_type(2)));
__device__ __forceinline__ unsigned cvt_pk_bf16(float lo, float hi) { f32x2 v = {lo, hi}; return __builtin_bit_cast(unsigned, __builtin_convertvector(v, bf16x2_t)); }
__device__ __forceinline__ unsigned f2bf(float f) { return (unsigned)__builtin_bit_cast(unsigned short, (__bf16)f); }
__device__ __forceinline__ unsigned pk2(float lo, float hi) { return cvt_pk_bf16(lo, hi); }
__device__ __forceinline__ float bflo(unsigned w) { return __builtin_bit_cast(float, w << 16); }
__device__ __forceinline__ float bfhi(unsigned w) { return __builtin_bit_cast(float, w & 0xffff0000u); }
__device__ __forceinline__ float wave_sum(float v) {
#pragma unroll
    for (int o = 1; o < 64; o <<= 1) v += __shfl_xor(v, o);
    return v;
}
__device__ __forceinline__ float sigmoid_f(float x) { return __builtin_amdgcn_rcpf(1.0f + __builtin_amdgcn_exp2f(-1.4426950408889634f * x)); }
__device__ __forceinline__ f32x2 gelu_pk(f32x2 v) {
    const f32x2 av = __builtin_elementwise_abs(v), d = av * 0.2316418882f + 1.0f;
    f32x2 t; t.x = __builtin_amdgcn_rcpf(d.x); t.y = __builtin_amdgcn_rcpf(d.y);
    f32x2 q = t * 0.5307027145f + (-0.7265760135f); q = q * t + 0.7107068705f; q = q * t + (-0.142248368f); q = q * t + 0.127414796f; q = q * t;
    const f32x2 s = (v * v) * (-0.72134752044f);
    f32x2 e; e.x = __builtin_amdgcn_exp2f(s.x); e.y = __builtin_amdgcn_exp2f(s.y);
    const f32x2 m = v * (q * e), r = v - m;
    f32x2 o; o.x = v.x < 0.f ? m.x : r.x; o.y = v.y < 0.f ? m.y : r.y; return o;
}
__device__ __forceinline__ f32x4 gelu4(f32x4 v) { f32x2 a = gelu_pk((f32x2){v[0], v[1]}), b = gelu_pk((f32x2){v[2], v[3]}); return (f32x4){a.x, a.y, b.x, b.y}; }
__device__ __forceinline__ u32x4 pack8(f32x4 v0, f32x4 v1) { u32x4 w; w.x = cvt_pk_bf16(v0[0], v0[1]); w.y = cvt_pk_bf16(v0[2], v0[3]); w.z = cvt_pk_bf16(v1[0], v1[1]); w.w = cvt_pk_bf16(v1[2], v1[3]); return w; }

namespace pg8 {
constexpr int BM = 256, BK = 64, HALF = 128, HTB = HALF * BK * 2, STAGE_BYTES = 8 * HTB, NXCD = 8, WGM = 8;
__host__ __device__ __forceinline__ int lds_byte(int r, int c) { const int st = (r >> 4) * 2 + (c >> 5), rr = r & 15, cc = c & 31, ob = rr * 64 + cc * 2; return st * 1024 + (ob ^ (((ob >> 9) & 1) << 5)); }
__host__ __device__ __forceinline__ void stage_rc(int b, int& R, int& C) { const int st = b / 1024, sb = b % 1024, swz = sb ^ (((sb >> 9) & 1) << 5); R = (st >> 1) * 16 + swz / 64; C = (st & 1) * 32 + (swz % 64) / 2; }
__host__ __device__ __forceinline__ int perm32(int rho) { const int n = rho >> 4, i = rho & 15; return 8 * (i >> 2) + 4 * n + (i & 3); }

struct Unit { const char* A; const char* B; int pm, pn, grp; };

struct TileOrder {
    int nM, nN, upg, total, G, c;
    __device__ __forceinline__ void init(int nM_, int nN_, int ngrp, int G_, int c_) { nM = nM_; nN = nN_; upg = nM * nN; total = upg * ngrp; G = G_; c = c_; }
    __device__ __forceinline__ bool tile(int i, int& grp, int& pm, int& pn) const {
        const int L = i * G + c; if (L >= total) return false;
        grp = L / upg; int wgid = L - grp * upg;
        { const int nwg = upg, q = nwg / NXCD, r = nwg % NXCD, xcd = wgid % NXCD, off = wgid / NXCD; wgid = (xcd < r ? xcd * (q + 1) : r * (q + 1) + (xcd - r) * q) + off; }
        const int nig = WGM * nN, gid = wgid / nig, fm = gid * WGM, gsz = (nM - fm) < WGM ? (nM - fm) : WGM;
        pm = fm + ((wgid % nig) % gsz); pn = (wgid % nig) / gsz; return true;
    }
};
struct DenseSched {
    static constexpr bool GATHER = false;
    TileOrder T; const char* A; const char* B; size_t a_grp, b_grp; int lda, K;
    __device__ __forceinline__ bool next(int i, Unit& u) const {
        int g, pm, pn; if (!T.tile(i, g, pm, pn)) return false;
        u.pm = pm; u.pn = pn; u.grp = g; u.A = A + (size_t)g * a_grp + (size_t)pm * BM * lda * 2; u.B = B + (size_t)g * b_grp + (size_t)pn * BM * K * 2; return true;
    }
    __device__ __forceinline__ unsigned a_off(const Unit&, int r) const { return (unsigned)(r * lda) * 2u; }
};
struct GatherSched {
    static constexpr bool GATHER = true;
    TileOrder T; const char* A; const char* B; size_t b_grp; const int* idx; int rows_per_grp, K;
    __device__ __forceinline__ bool next(int i, Unit& u) const {
        int g, pm, pn; if (!T.tile(i, g, pm, pn)) return false;
        u.pm = pm; u.pn = pn; u.grp = g; u.A = A; u.B = B + (size_t)g * b_grp + (size_t)pn * BM * K * 2; return true;
    }
    __device__ __forceinline__ unsigned a_off(const Unit& u, int r) const { return (unsigned)idx[u.grp * rows_per_grp + u.pm * BM + r] * (unsigned)(K * 2); }
};

template <class Epi, class Sched>
__device__ __forceinline__ void gemm_phase(LAS unsigned char* lds, const Sched& S, const Epi& E) {
    const int tid = threadIdx.x, wid = __builtin_amdgcn_readfirstlane(tid >> 6), lane = tid & 63, wr = wid >> 2, wc = wid & 3, fr = lane & 15, fq = lane >> 4;
    const int K = S.K, nt = K / BK;
    int Rr[2], Cc[2]; unsigned voffB[2];
#pragma unroll
    for (int i = 0; i < 2; ++i) { stage_rc(tid * 16 + i * 8192, Rr[i], Cc[i]); const int Rb = Epi::PERM ? ((Rr[i] & ~31) + perm32(Rr[i] & 31)) : Rr[i]; voffB[i] = (unsigned)(Rb * K + Cc[i]) * 2u; }
    const size_t kstep = (size_t)(BK * 2);
    const size_t hstepB = (size_t)HALF * K * 2;
    const unsigned ldsw = (unsigned)wid * 1024u;
    const int aoff = lds_byte(wr * 64 + fr, fq * 8), boff = lds_byte(wc * 32 + fr, fq * 8);
#define PG8_SA(b, h) (((b) * 2 + (h)) * HTB)
#define PG8_SB(b, h) ((4 + (b) * 2 + (h)) * HTB)
#define PG8_STAGE2(bufoff, gbase, o0, o1) do { \
        __builtin_amdgcn_global_load_lds((const unsigned*)((const char*)(gbase) + (o0)), (LAS unsigned*)(lds + (bufoff) + ldsw), 16, 0, 0); \
        __builtin_amdgcn_global_load_lds((const unsigned*)((const char*)(gbase) + (o1)), (LAS unsigned*)(lds + (bufoff) + ldsw + 8192), 16, 0, 0); } while (0)
#define PG8_STAGEB(bufoff, gbase) PG8_STAGE2(bufoff, gbase, voffB[0], voffB[1])
#define PG8_LDA(dst, b, h) do { _Pragma("unroll") for (int m = 0; m < 4; ++m) _Pragma("unroll") for (int k = 0; k < 2; ++k) dst[m][k] = *(const LAS bf16x8*)(lds + PG8_SA(b, h) + aoff + m * 2048 + k * 1024); } while (0)
#define PG8_LDB(dst, b, h) do { _Pragma("unroll") for (int n = 0; n < 2; ++n) _Pragma("unroll") for (int k = 0; k < 2; ++k) dst[n][k] = *(const LAS bf16x8*)(lds + PG8_SB(b, h) + boff + n * 2048 + k * 1024); } while (0)
#define PG8_MMA(ai, bj, At, Bt) do { __builtin_amdgcn_s_setprio(1); _Pragma("unroll") for (int m = 0; m < 4; ++m) _Pragma("unroll") for (int n = 0; n < 2; ++n) _Pragma("unroll") for (int k = 0; k < 2; ++k) \
        acc[ai][bj][m][n] = __builtin_amdgcn_mfma_f32_16x16x32_bf16(Bt[n][k], At[m][k], acc[ai][bj][m][n], 0, 0, 0); __builtin_amdgcn_s_setprio(0); } while (0)
#define PG8_WAIT_V(n) asm volatile("s_waitcnt vmcnt(" #n ")" ::: "memory")
#define PG8_WAIT_L(n) asm volatile("s_waitcnt lgkmcnt(" #n ")" ::: "memory")
#define PG8_BAR __builtin_amdgcn_s_barrier()
#define PG8_SCHED __builtin_amdgcn_sched_barrier(0)
    Unit cur, nxt; int ui = 0;
    if (!S.next(0, cur)) return;
    f32x4 acc[2][2][4][2];
#pragma unroll
    for (int a = 0; a < 2; ++a)
#pragma unroll
        for (int b = 0; b < 2; ++b)
#pragma unroll
            for (int m = 0; m < 4; ++m)
#pragma unroll
                for (int n = 0; n < 2; ++n) acc[a][b][m][n] = (f32x4){0.f, 0.f, 0.f, 0.f};
    bf16x8 At[4][2], B0[2][2], B1[2][2];
    unsigned vA00, vA01, vA10, vA11, vN00, vN01, vN10, vN11;
    vA00 = S.a_off(cur, Rr[0]) + Cc[0] * 2; vA01 = S.a_off(cur, Rr[1]) + Cc[1] * 2; vA10 = S.a_off(cur, HALF + Rr[0]) + Cc[0] * 2; vA11 = S.a_off(cur, HALF + Rr[1]) + Cc[1] * 2;
    const char* cA = cur.A; const char* cB = cur.B;
    PG8_STAGEB(PG8_SB(0, 0), cB); PG8_STAGEB(PG8_SB(0, 1), cB + hstepB); PG8_STAGE2(PG8_SA(0, 0), cA, vA00, vA01); PG8_STAGE2(PG8_SA(0, 1), cA, vA10, vA11);
    if (wr == 1) PG8_BAR;
    PG8_WAIT_V(2); PG8_BAR;
    PG8_STAGEB(PG8_SB(1, 0), cB + kstep); PG8_STAGE2(PG8_SA(1, 0), cA + kstep, vA00, vA01); PG8_STAGEB(PG8_SB(1, 1), cB + hstepB + kstep);
    PG8_WAIT_V(6); PG8_BAR;
    for (;;) {
        const bool has_next = S.next(ui + 1, nxt);
        const char* nA = has_next ? nxt.A : cA; const char* nB = has_next ? nxt.B : cB;
        if (Sched::GATHER) {
            if (has_next) { vN00 = S.a_off(nxt, Rr[0]) + Cc[0] * 2; vN01 = S.a_off(nxt, Rr[1]) + Cc[1] * 2; vN10 = S.a_off(nxt, HALF + Rr[0]) + Cc[0] * 2; vN11 = S.a_off(nxt, HALF + Rr[1]) + Cc[1] * 2; }
            else { vN00 = vA00; vN01 = vA01; vN10 = vA10; vN11 = vA11; }
        } else { vN00 = vA00; vN01 = vA01; vN10 = vA10; vN11 = vA11; }
        for (int t = 0; t < nt; t += 2) {
            const bool last = (t == nt - 2);
            const char* a1 = cA + (size_t)(t + 1) * kstep;
            const char* a2 = last ? nA : cA + (size_t)(t + 2) * kstep; const char* b2 = last ? nB : cB + (size_t)(t + 2) * kstep;
            const char* a3 = a2 + kstep; const char* b3 = b2 + kstep;
            const unsigned o00 = (Sched::GATHER && last) ? vN00 : vA00, o01 = (Sched::GATHER && last) ? vN01 : vA01, o10 = (Sched::GATHER && last) ? vN10 : vA10, o11 = (Sched::GATHER && last) ? vN11 : vA11;
            PG8_LDB(B0, 0, 0); PG8_LDB(B1, 0, 1); PG8_SCHED; PG8_LDA(At, 0, 0); PG8_STAGE2(PG8_SA(1, 1), a1, vA10, vA11);
            PG8_WAIT_V(8); PG8_WAIT_L(0); PG8_BAR; PG8_MMA(0, 0, At, B0); PG8_MMA(0, 1, At, B1); PG8_BAR; PG8_SCHED;
            PG8_LDA(At, 0, 1); PG8_STAGEB(PG8_SB(0, 0), b2); PG8_STAGEB(PG8_SB(0, 1), b2 + hstepB); PG8_STAGE2(PG8_SA(0, 0), a2, o00, o01);
            PG8_WAIT_V(8); PG8_WAIT_L(0); PG8_BAR; PG8_MMA(1, 0, At, B0); PG8_MMA(1, 1, At, B1); PG8_BAR; PG8_SCHED;
            PG8_LDB(B0, 1, 0); PG8_LDB(B1, 1, 1); PG8_SCHED; PG8_LDA(At, 1, 0); PG8_STAGE2(PG8_SA(0, 1), a2, o10, o11);
            PG8_WAIT_V(8); PG8_WAIT_L(0); PG8_BAR; PG8_MMA(0, 0, At, B0); PG8_MMA(0, 1, At, B1); PG8_BAR; PG8_SCHED;
            PG8_LDA(At, 1, 1); PG8_STAGEB(PG8_SB(1, 0), b3); PG8_STAGEB(PG8_SB(1, 1), b3 + hstepB); PG8_STAGE2(PG8_SA(1, 0), a3, o00, o01);
            PG8_WAIT_V(8); PG8_WAIT_L(0); PG8_BAR; PG8_MMA(1, 0, At, B0); PG8_MMA(1, 1, At, B1); PG8_BAR; PG8_SCHED;
        }
        if (wr == 0) PG8_BAR;
        E(acc, cur, wr, wc, fr, fq);
        if (!has_next) break;
#pragma unroll
        for (int a = 0; a < 2; ++a)
#pragma unroll
            for (int b = 0; b < 2; ++b)
#pragma unroll
                for (int m = 0; m < 4; ++m)
#pragma unroll
                    for (int n = 0; n < 2; ++n) acc[a][b][m][n] = (f32x4){0.f, 0.f, 0.f, 0.f};
        cur = nxt; cA = nA; cB = nB; ++ui;
        vA00 = vN00; vA01 = vN01; vA10 = vN10; vA11 = vN11;
        if (wr == 1) PG8_BAR;
    }
    PG8_WAIT_V(0);
    PG8_BAR;
#undef PG8_SA
#undef PG8_SB
#undef PG8_STAGE2
#undef PG8_STAGEB
#undef PG8_LDA
#undef PG8_LDB
#undef PG8_MMA
#undef PG8_WAIT_V
#undef PG8_WAIT_L
#undef PG8_BAR
#undef PG8_SCHED
}

#define EPI_LOOP_ROWS for (int ai = 0; ai < 2; ++ai) _Pragma("unroll") for (int m = 0; m < 4; ++m)
struct EpiWin {
    static constexpr bool PERM = true;
    bf16* UV; bf16* ACOMB; bf16* GATES; const float* b_gate;
    __device__ __forceinline__ void operator()(const f32x4 (&acc)[2][2][4][2], const Unit& u, int wr, int wc, int fr, int fq) const {
        const int row0 = u.pm * BM + wr * 64 + fr, cw = wc * 32 + 8 * fq;
        if (u.pn < 4) {
#pragma unroll
            EPI_LOOP_ROWS { bf16* rowp = UV + (size_t)(row0 + ai * HALF + m * 16) * 1024 + u.pn * BM + cw;
#pragma unroll
                for (int bj = 0; bj < 2; ++bj) *(u32x4*)(rowp + bj * HALF) = pack8(gelu4(acc[ai][bj][m][0]), gelu4(acc[ai][bj][m][1])); }
        } else if (u.pn == 4) {
#pragma unroll
            EPI_LOOP_ROWS { const int row = row0 + ai * HALF + m * 16, chunk = row >> 4, j = row & 15;
#pragma unroll
                for (int bj = 0; bj < 2; ++bj) { const int c = bj * HALF + cw, g = c >> 4, h0 = c & 15;
                    *(u32x4*)(ACOMB + ((size_t)g * NCHUNK + chunk) * 512 + j * 16 + h0) = pack8(acc[ai][bj][m][0], acc[ai][bj][m][1]); } }
        } else {
            const int gc0 = (u.pn - 5) * BM + cw;
            f32x4 bv[2][2];
#pragma unroll
            for (int bj = 0; bj < 2; ++bj)
#pragma unroll
                for (int n = 0; n < 2; ++n) bv[bj][n] = *(const f32x4*)(b_gate + gc0 + bj * HALF + 4 * n);
#pragma unroll
            EPI_LOOP_ROWS { bf16* rowp = GATES + (size_t)(row0 + ai * HALF + m * 16) * 2048 + gc0;
#pragma unroll
                for (int bj = 0; bj < 2; ++bj) { f32x4 v0 = acc[ai][bj][m][0] + bv[bj][0], v1 = acc[ai][bj][m][1] + bv[bj][1];
#pragma unroll
                    for (int j = 0; j < 4; ++j) { v0[j] = sigmoid_f(v0[j]); v1[j] = sigmoid_f(v1[j]); }
                    *(u32x4*)(rowp + bj * HALF) = pack8(v0, v1); } }
        }
    }
};
struct EpiCarry {
    static constexpr bool PERM = false;
    float* SLOC;
    __device__ __forceinline__ void operator()(const f32x4 (&acc)[2][2][4][2], const Unit& u, int wr, int wc, int fr, int fq) const {
        const int row0 = u.pm * BM + wr * 64 + fr, col0 = wc * 32 + 4 * fq;
#pragma unroll
        EPI_LOOP_ROWS { float* rowp = SLOC + ((size_t)u.grp * NCHUNK + row0 + ai * HALF + m * 16) * 256 + col0;
#pragma unroll
            for (int bj = 0; bj < 2; ++bj)
#pragma unroll
                for (int n = 0; n < 2; ++n) *(f32x4*)(rowp + bj * HALF + n * 16) = acc[ai][bj][m][n]; }
    }
};
struct EpiS5 {
    static constexpr bool PERM = true;
    bf16* Y;
    __device__ __forceinline__ void operator()(const f32x4 (&acc)[2][2][4][2], const Unit& u, int wr, int wc, int fr, int fq) const {
        const int row0 = u.pm * BM + wr * 64 + fr, cw = wc * 32 + 8 * fq;
#pragma unroll
        EPI_LOOP_ROWS { const int chunk = row0 + ai * HALF + m * 16;
#pragma unroll
            for (int bj = 0; bj < 2; ++bj) { const int c = bj * HALF + cw, i = c >> 4, h0 = c & 15;
                *(u32x4*)(Y + ((size_t)chunk * TCH + i) * 256 + u.grp * 16 + h0) = pack8(gelu4(acc[ai][bj][m][0]), gelu4(acc[ai][bj][m][1])); } }
    }
};
struct EpiGlu {
    static constexpr bool PERM = true;
    const bf16* Y; bf16* BRB; const float* b_glu;
    __device__ __forceinline__ void operator()(const f32x4 (&acc)[2][2][4][2], const Unit& u, int wr, int wc, int fr, int fq) const {
        const int row0 = u.pm * BM + wr * 64 + fr, cw = wc * 32 + 8 * fq;
        f32x4 bv[2][2];
#pragma unroll
        for (int bj = 0; bj < 2; ++bj)
#pragma unroll
            for (int n = 0; n < 2; ++n) bv[bj][n] = *(const f32x4*)(b_glu + cw + bj * HALF + 4 * n);
#pragma unroll
        EPI_LOOP_ROWS { const size_t off = (size_t)(row0 + ai * HALF + m * 16) * 256 + cw;
#pragma unroll
            for (int bj = 0; bj < 2; ++bj) { const u32x4 yv = *(const u32x4*)(Y + off + bj * HALF);
                f32x4 v0 = acc[ai][bj][m][0] + bv[bj][0], v1 = acc[ai][bj][m][1] + bv[bj][1];
                v0[0] = bflo(yv.x) * sigmoid_f(v0[0]); v0[1] = bfhi(yv.x) * sigmoid_f(v0[1]); v0[2] = bflo(yv.y) * sigmoid_f(v0[2]); v0[3] = bfhi(yv.y) * sigmoid_f(v0[3]);
                v1[0] = bflo(yv.z) * sigmoid_f(v1[0]); v1[1] = bfhi(yv.z) * sigmoid_f(v1[1]); v1[2] = bflo(yv.w) * sigmoid_f(v1[2]); v1[3] = bfhi(yv.w) * sigmoid_f(v1[3]);
                *(u32x4*)(BRB + off + bj * HALF) = pack8(v0, v1); }
            asm volatile("" ::: "memory"); }
    }
};
template <bool ADD> struct EpiUp {
    static constexpr bool PERM = true;
    bf16* MERGED; const bf16* GATES; int goff;
    __device__ __forceinline__ void operator()(const f32x4 (&acc)[2][2][4][2], const Unit& u, int wr, int wc, int fr, int fq) const {
        const int row0 = u.pm * BM + wr * 64 + fr, col0 = u.pn * BM + wc * 32 + 8 * fq;
#pragma unroll
        EPI_LOOP_ROWS { const size_t row = (size_t)(row0 + ai * HALF + m * 16);
#pragma unroll
            for (int bj = 0; bj < 2; ++bj) { const u32x4 gv = *(const u32x4*)(GATES + row * 2048 + goff + col0 + bj * HALF);
                f32x4 v0 = acc[ai][bj][m][0], v1 = acc[ai][bj][m][1];
                v0[0] *= bflo(gv.x); v0[1] *= bfhi(gv.x); v0[2] *= bflo(gv.y); v0[3] *= bfhi(gv.y); v1[0] *= bflo(gv.z); v1[1] *= bfhi(gv.z); v1[2] *= bflo(gv.w); v1[3] *= bfhi(gv.w);
                bf16* mp = MERGED + row * 1024 + col0 + bj * HALF;
                if (ADD) { const u32x4 pv = *(const u32x4*)mp;
                    v0[0] += bflo(pv.x); v0[1] += bfhi(pv.x); v0[2] += bflo(pv.y); v0[3] += bfhi(pv.y); v1[0] += bflo(pv.z); v1[1] += bfhi(pv.z); v1[2] += bflo(pv.w); v1[3] += bfhi(pv.w); }
                *(u32x4*)mp = pack8(v0, v1); }
            asm volatile("" ::: "memory"); }
    }
};
struct EpiOut {
    static constexpr bool PERM = false;
    const float* X; float* X1;
    __device__ __forceinline__ void operator()(const f32x4 (&acc)[2][2][4][2], const Unit& u, int wr, int wc, int fr, int fq) const {
        const int row0 = u.pm * BM + wr * 64 + fr, col0 = u.pn * BM + wc * 32 + 4 * fq;
#pragma unroll
        EPI_LOOP_ROWS { const size_t off = (size_t)(row0 + ai * HALF + m * 16) * 1024 + col0;
#pragma unroll
            for (int bj = 0; bj < 2; ++bj)
#pragma unroll
                for (int n = 0; n < 2; ++n) { const f32x4 xv = *(const f32x4*)(X + off + bj * HALF + n * 16); *(f32x4*)(X1 + off + bj * HALF + n * 16) = xv + acc[ai][bj][m][n]; }
            asm volatile("" ::: "memory"); }
    }
};
struct EpiHid {
    static constexpr bool PERM = true;
    bf16* HID;
    __device__ __forceinline__ void operator()(const f32x4 (&acc)[2][2][4][2], const Unit& u, int wr, int wc, int fr, int fq) const {
        const int row0 = u.pm * BM + wr * 64 + fr, col0 = u.pn * HALF + wc * 32 + 8 * fq;
#pragma unroll
        EPI_LOOP_ROWS { const size_t row = (size_t)u.grp * (NB * CAP) + row0 + ai * HALF + m * 16;
            f32x4 v0 = acc[ai][0][m][0], v1 = acc[ai][0][m][1];
#pragma unroll
            for (int j = 0; j < 4; ++j) { v0[j] = v0[j] * sigmoid_f(v0[j]) * acc[ai][1][m][0][j]; v1[j] = v1[j] * sigmoid_f(v1[j]) * acc[ai][1][m][1][j]; }
            *(u32x4*)(HID + row * FF + col0) = pack8(v0, v1); }
    }
};
struct EpiDown {
    static constexpr bool PERM = true;
    bf16* YS; const float* GATEV;
    __device__ __forceinline__ void operator()(const f32x4 (&acc)[2][2][4][2], const Unit& u, int wr, int wc, int fr, int fq) const {
        const int row0 = u.pm * BM + wr * 64 + fr, col0 = u.pn * BM + wc * 32 + 8 * fq;
#pragma unroll
        EPI_LOOP_ROWS { const size_t row = (size_t)u.grp * (NB * CAP) + row0 + ai * HALF + m * 16; const float gt = GATEV[row];
#pragma unroll
            for (int bj = 0; bj < 2; ++bj) *(u32x4*)(YS + row * 1024 + col0 + bj * HALF) = pack8(acc[ai][bj][m][0] * gt, acc[ai][bj][m][1] * gt); }
    }
};
}

struct Args { const float* in[27]; float* out; unsigned char* ws; int ph_lo, ph_hi; };

struct Frame {
    LAS unsigned char* lds; int tid, lane, wave, G, bid;
    unsigned char* ws; const float* const* in;
};

__device__ __forceinline__ void transpose_item(const float* W, int N, bf16* WT, int ldt, int k0, int n0, int drow0, LAS float* scr, int lane) {
#pragma unroll 8
    for (int i = 0; i < 32; ++i) { const int kk = 2 * i + (lane >> 5); scr[kk * 33 + (lane & 31)] = W[(size_t)(k0 + kk) * N + n0 + (lane & 31)]; }
    asm volatile("s_waitcnt lgkmcnt(0)" ::: "memory");
    const int c = lane & 7;
#pragma unroll
    for (int j = 0; j < 4; ++j) { const int n = (lane >> 3) + 8 * j; const LAS float* s = scr + (8 * c) * 33 + n;
        u32x4 o; o.x = pk2(s[0 * 33], s[1 * 33]); o.y = pk2(s[2 * 33], s[3 * 33]); o.z = pk2(s[4 * 33], s[5 * 33]); o.w = pk2(s[6 * 33], s[7 * 33]);
        *(u32x4*)(WT + (size_t)(drow0 + n) * ldt + k0 + 8 * c) = o; }
    asm volatile("s_waitcnt lgkmcnt(0)" ::: "memory");
}

__device__ __forceinline__ void p0_s5_tables(const Frame& F) {
    const float* lam_re = F.in[8]; const float* lam_im = F.in[9]; const float* log_dt = F.in[10];
    const float* b_re = F.in[11]; const float* b_im = F.in[12]; const float* c_re = F.in[13]; const float* c_im = F.in[14]; const float* d_skip = F.in[15];
    bf16* BMAIN = (bf16*)(F.ws + WS_BMAIN); bf16* BCO = (bf16*)(F.ws + WS_BCO); float* LT = (float*)(F.ws + WS_LT);
    LAS float* PW = (LAS float*)F.lds;
    LAS float* BB = PW + 2 * 17 * 64 * 2;
    for (int wg = F.bid; wg < 256; wg += F.G) {
        const int g = wg >> 4, sl = wg & 15, tid = F.tid;
        __syncthreads();
        if (tid < 128) {
            const int dir = tid >> 6, p = tid & 63, li = (dir * 16 + g) * 64 + p;
            const float lr = lam_re[li], lim = lam_im[li], dt = expf(log_dt[dir * 16 + g]);
            float k_re = 0.f, k_im = 0.f;
            for (int d = 0; d <= 16; ++d) {
                const float mag = expf(lr * dt * (float)d);
                double rev = (double)lim * (double)dt * (double)d * 0.15915494309189535; rev -= rint(rev);
                const float ang = (float)(rev * 6.283185307179586);
                const float cs = cosf(ang), sn = sinf(ang);
                PW[((dir * 17 + d) * 64 + p) * 2 + 0] = mag * cs; PW[((dir * 17 + d) * 64 + p) * 2 + 1] = mag * sn;
                if (d == 1) {
                    const float sh = sinf(0.5f * ang); const float nr = expm1f(lr * dt) * cs - 2.f * sh * sh, ni = mag * sn;
                    const float den = 1.f / (lr * lr + lim * lim); k_re = (nr * lr + ni * lim) * den; k_im = (ni * lr - nr * lim) * den;
                }
            }
            for (int h = 0; h < 16; ++h) { const float br = b_re[li * 16 + h], bi = b_im[li * 16 + h];
                BB[((dir * 64 + p) * 16 + h) * 2 + 0] = k_re * br - k_im * bi; BB[((dir * 64 + p) * 16 + h) * 2 + 1] = k_re * bi + k_im * br; }
            if (sl == 0) { LT[li * 2 + 0] = PW[((dir * 17 + 16) * 64 + p) * 2 + 0]; LT[li * 2 + 1] = PW[((dir * 17 + 16) * 64 + p) * 2 + 1]; }
        }
        __syncthreads();
        const int i = sl;
        for (int mm = 0; mm < 16; ++mm) {
            const int h = mm, k = tid; float val;
            if (k < 256) {
                const int j = k >> 4, hp = k & 15; float s = 0.f;
                if (j != i) { const int dir = j < i ? 0 : 1, d = j < i ? i - j : j - i; const float* cr = c_re + ((dir * 16 + g) * 16 + h) * 64; const float* ci = c_im + ((dir * 16 + g) * 16 + h) * 64;
                    for (int p = 0; p < 64; ++p) { const float wr_ = PW[((dir * 17 + d) * 64 + p) * 2], wi_ = PW[((dir * 17 + d) * 64 + p) * 2 + 1], br = BB[((dir * 64 + p) * 16 + hp) * 2], bi = BB[((dir * 64 + p) * 16 + hp) * 2 + 1];
                        const float zr = wr_ * br - wi_ * bi, zi = wr_ * bi + wi_ * br; s += cr[p] * zr - ci[p] * zi; } }
                else { for (int dir = 0; dir < 2; ++dir) { const float* cr = c_re + ((dir * 16 + g) * 16 + h) * 64; const float* ci = c_im + ((dir * 16 + g) * 16 + h) * 64;
                        for (int p = 0; p < 64; ++p) { const float br = BB[((dir * 64 + p) * 16 + hp) * 2], bi = BB[((dir * 64 + p) * 16 + hp) * 2 + 1]; s += cr[p] * br - ci[p] * bi; } }
                    if (h == hp) s += d_skip[g * 16 + h]; }
                val = s;
            } else {
                const int q = k - 256, dir = q >> 7, im = (q >> 6) & 1, p = q & 63, d = dir == 0 ? i + 1 : 16 - i;
                const float cr = c_re[((dir * 16 + g) * 16 + h) * 64 + p], ci = c_im[((dir * 16 + g) * 16 + h) * 64 + p], wr_ = PW[((dir * 17 + d) * 64 + p) * 2], wi_ = PW[((dir * 17 + d) * 64 + p) * 2 + 1];
                val = im ? -(cr * wi_ + ci * wr_) : (cr * wr_ - ci * wi_);
            }
            BMAIN[((size_t)g * 256 + i * 16 + h) * 512 + k] = (bf16)f2bf(val);
        }
        for (int mm = 0; mm < 8; ++mm) {
            const int e = tid + 512 * mm, ql = e >> 8, k = e & 255, q = sl * 16 + ql, dir = q >> 7, im = (q >> 6) & 1, p = q & 63, j = k >> 4, hp = k & 15, d = dir == 0 ? 15 - j : j;
            const float wr_ = PW[((dir * 17 + d) * 64 + p) * 2], wi_ = PW[((dir * 17 + d) * 64 + p) * 2 + 1], br = BB[((dir * 64 + p) * 16 + hp) * 2], bi = BB[((dir * 64 + p) * 16 + hp) * 2 + 1];
            BCO[((size_t)g * 256 + q) * 256 + k] = (bf16)f2bf(im ? (wr_ * bi + wi_ * br) : (wr_ * br - wi_ * bi));
        }
    }
    __syncthreads();
}

__device__ __forceinline__ void p0_weights(const Frame& F) {
    LAS float* scr = (LAS float*)(F.lds + F.wave * 16384);
    const int gw = F.bid * NWAVES + F.wave, NGW = F.G * NWAVES, lane = F.lane;
    bf16* WIN_T = (bf16*)(F.ws + WS_WIN_T); bf16* WUPA_T = (bf16*)(F.ws + WS_WUPA_T); bf16* WUPB_T = (bf16*)(F.ws + WS_WUPB_T); bf16* WOUT_T = (bf16*)(F.ws + WS_WOUT_T);
    bf16* WGLU_T = (bf16*)(F.ws + WS_WGLU_T); bf16* WGU_T = (bf16*)(F.ws + WS_WGU_T); bf16* WD_T = (bf16*)(F.ws + WS_WD_T); bf16* WSB = (bf16*)(F.ws + WS_WS);
    constexpr int I_IN = 16 * 104, I_UA = 8 * 32, I_UB = 4 * 32, I_OUT = 16 * 32, I_GLU = 4 * 8, I_G = 16 * 1024, I_D = 16 * 1024;
    constexpr int NITEMS = I_IN + I_UA + I_UB + I_OUT + I_GLU + 2 * I_G + I_D;
    for (int it = gw; it < NITEMS; it += NGW) {
        int r = it;
        if (r < I_IN) { const int kb = r / 104, nb = r % 104; transpose_item(F.in[2], PT, WIN_T, 1024, kb * 64, nb * 32, nb * 32, scr, lane); continue; } r -= I_IN;
        if (r < I_UA) { const int kb = r / 32, nb = r % 32; transpose_item(F.in[18], 1024, WUPA_T, 512, kb * 64, nb * 32, nb * 32, scr, lane); continue; } r -= I_UA;
        if (r < I_UB) { const int kb = r / 32, nb = r % 32; transpose_item(F.in[19], 1024, WUPB_T, 256, kb * 64, nb * 32, nb * 32, scr, lane); continue; } r -= I_UB;
        if (r < I_OUT) { const int kb = r / 32, nb = r % 32; transpose_item(F.in[20], 1024, WOUT_T, 1024, kb * 64, nb * 32, nb * 32, scr, lane); continue; } r -= I_OUT;
        if (r < I_GLU) { const int kb = r / 8, nb = r % 8; transpose_item(F.in[16], 256, WGLU_T, 256, kb * 64, nb * 32, nb * 32, scr, lane); continue; } r -= I_GLU;
        if (r < 2 * I_G) { const int up = r >= I_G ? 1 : 0; if (up) r -= I_G; const int e = r >> 10, w = r & 1023, kb = w >> 6, nb = w & 63, n0 = nb * 32;
            transpose_item(F.in[up ? 24 : 23] + (size_t)e * 1024 * 2048, 2048, WGU_T + (size_t)e * 4096 * 1024, 1024, kb * 64, n0, (n0 >> 7) * 256 + (n0 & 127) + up * 128, scr, lane); continue; } r -= 2 * I_G;
        { const int e = r >> 10, w = r & 1023, kb = w >> 5, nb = w & 31; transpose_item(F.in[25] + (size_t)e * 2048 * 1024, 1024, WD_T + (size_t)e * 1024 * 2048, 2048, kb * 64, nb * 32, nb * 32, scr, lane); }
    }
    for (int i = F.bid * NTHR + F.tid; i < 8 * 128 * 128; i += F.G * NTHR) WSB[i] = (bf16)f2bf(F.in[6][i]);
}

__device__ __forceinline__ void rms_row(const float* xrow, const float* g, int lane, f32x4 (&v)[4]) {
    const f32x4* xr = (const f32x4*)xrow + lane; float s = 0.f;
#pragma unroll
    for (int j = 0; j < 4; ++j) { v[j] = xr[64 * j]; s += (v[j].x * v[j].x + v[j].y * v[j].y) + (v[j].z * v[j].z + v[j].w * v[j].w); }
    const float r = 1.f / sqrtf(wave_sum(s) * (1.f / 1024.f) + EPS);
#pragma unroll
    for (int j = 0; j < 4; ++j) { const f32x4 gv = ((const f32x4*)g)[lane + 64 * j]; v[j] = v[j] * r * gv; }
}
__device__ __forceinline__ void store_row_bf16(bf16* orow, int lane, const f32x4 (&v)[4]) {
    u32x2* o8 = (u32x2*)orow + lane;
#pragma unroll
    for (int j = 0; j < 4; ++j) { u32x2 w; w.x = pk2(v[j].x, v[j].y); w.y = pk2(v[j].z, v[j].w); o8[64 * j] = w; }
}

__device__ __forceinline__ void p1_rmsnorm(const Frame& F) {
    const float* x = F.in[0]; const float* g = F.in[1]; bf16* H1 = (bf16*)(F.ws + WS_H1);
    const int gw = F.bid * NWAVES + F.wave, NGW = F.G * NWAVES;
    for (int m = gw; m < NTOK; m += NGW) { f32x4 v[4]; rms_row(x + (size_t)m * 1024, g, F.lane, v); store_row_bf16(H1 + (size_t)m * 1024, F.lane, v); }
}

__device__ __forceinline__ void p3_gmlp(const Frame& F) {
    const bf16* UV = (const bf16*)(F.ws + WS_UV); const bf16* WSB = (const bf16*)(F.ws + WS_WS); bf16* BRA = (bf16*)(F.ws + WS_BRA);
    const float* ln_g = F.in[4]; const float* ln_b = F.in[5]; const float* b_s = F.in[7];
    LAS bf16* vnT = (LAS bf16*)F.lds;
    LAS float* stats = (LAS float*)(F.lds + 32768);
    const int tid = F.tid, lane = F.lane, w = F.wave;
    for (int chunk = F.bid; chunk < NTOK / 128; chunk += F.G) {
        const size_t tok0 = (size_t)chunk * 128;
        __syncthreads();
        for (int tt = 0; tt < 16; ++tt) {
            const int s = w * 16 + tt; const u32x4 raw = *(const u32x4*)(UV + (tok0 + s) * 1024 + 512 + lane * 8);
            float f[8] = {bflo(raw.x), bfhi(raw.x), bflo(raw.y), bfhi(raw.y), bflo(raw.z), bfhi(raw.z), bflo(raw.w), bfhi(raw.w)};
            float sum = 0.f;
#pragma unroll
            for (int e = 0; e < 8; ++e) sum += f[e];
            const float mean = wave_sum(sum) * (1.f / 512.f); float q = 0.f;
#pragma unroll
            for (int e = 0; e < 8; ++e) { const float d = f[e] - mean; q += d * d; }
            const float rstd = 1.f / sqrtf(wave_sum(q) * (1.f / 512.f) + EPS);
            if (lane == 0) { stats[s * 2] = mean; stats[s * 2 + 1] = rstd; }
        }
        __syncthreads();
        for (int g = 0; g < 8; ++g) {
#pragma unroll
            for (int qq = 0; qq < 2; ++qq) {
                const int pc = tid + 512 * qq, s = pc >> 3, c8 = (pc & 7) * 8; const u32x4 raw = *(const u32x4*)(UV + (tok0 + s) * 1024 + 512 + g * 64 + c8);
                const float mean = stats[s * 2], rstd = stats[s * 2 + 1];
                float f[8] = {bflo(raw.x), bfhi(raw.x), bflo(raw.y), bfhi(raw.y), bflo(raw.z), bfhi(raw.z), bflo(raw.w), bfhi(raw.w)};
#pragma unroll
                for (int e = 0; e < 8; ++e) { const int ch = g * 64 + c8 + e; vnT[(c8 + e) * 136 + s] = (bf16)f2bf((f[e] - mean) * rstd * ln_g[ch] + ln_b[ch]); }
            }
            __syncthreads();
            const int t = w * 16 + (lane & 15), kq = (lane >> 4) * 8;
            f32x4 acc[4];
#pragma unroll
            for (int ct = 0; ct < 4; ++ct) acc[ct] = (f32x4){0.f, 0.f, 0.f, 0.f};
#pragma unroll
            for (int kk = 0; kk < 4; ++kk) {
                const bf16x8 wf = *(const bf16x8*)(WSB + ((size_t)g * 128 + t) * 128 + kk * 32 + kq);
#pragma unroll
                for (int ct = 0; ct < 4; ++ct) { const bf16x8 vf = *(const LAS bf16x8*)(vnT + (ct * 16 + (lane & 15)) * 136 + kk * 32 + kq);
                    acc[ct] = __builtin_amdgcn_mfma_f32_16x16x32_bf16(vf, wf, acc[ct], 0, 0, 0); }
            }
            const float bs = b_s[g * 128 + t];
#pragma unroll
            for (int ct = 0; ct < 4; ++ct) {
                const int ch = g * 64 + ct * 16 + (lane >> 4) * 4; const u32x2 uu = *(const u32x2*)(UV + (tok0 + t) * 1024 + ch);
                u32x2 o; o.x = pk2(bflo(uu.x) * (acc[ct][0] + bs), bfhi(uu.x) * (acc[ct][1] + bs)); o.y = pk2(bflo(uu.y) * (acc[ct][2] + bs), bfhi(uu.y) * (acc[ct][3] + bs));
                *(u32x2*)(BRA + (tok0 + t) * 512 + ch) = o;
            }
            __syncthreads();
        }
    }
}

__device__ __forceinline__ void p4_scan(const Frame& F) {
    const float* SLOC = (const float*)(F.ws + WS_SLOC); bf16* ACOMB = (bf16*)(F.ws + WS_ACOMB); const float* LT = (const float*)(F.ws + WS_LT);
    if (F.tid >= 128) return;
    for (int wg = F.bid; wg < 256; wg += F.G) {
        const int b = wg >> 4, g = wg & 15, dir = F.tid >> 6, p = F.tid & 63;
        const float lr = LT[((dir * 16 + g) * 64 + p) * 2], li = LT[((dir * 16 + g) * 64 + p) * 2 + 1];
        float xr = 0.f, xi = 0.f;
        const size_t rowbase = (size_t)g * NCHUNK + (size_t)b * CPS;
        for (int c0 = 0; c0 < CPS; c0 += 16) {
            float sr[16], si[16];
#pragma unroll
            for (int k = 0; k < 16; ++k) { const int c = dir ? (CPS - 1 - (c0 + k)) : (c0 + k); const float* sp = SLOC + (rowbase + c) * 256 + dir * 128 + p; sr[k] = sp[0]; si[k] = sp[64]; }
#pragma unroll
            for (int k = 0; k < 16; ++k) { const int c = dir ? (CPS - 1 - (c0 + k)) : (c0 + k); bf16* op = ACOMB + (rowbase + c) * 512 + 256 + dir * 128 + p;
                op[0] = (bf16)f2bf(xr); op[64] = (bf16)f2bf(xi);
                const float nr = lr * xr - li * xi + sr[k], ni = lr * xi + li * xr + si[k]; xr = nr; xi = ni; }
        }
    }
}

__device__ __forceinline__ void p9_norm_router(const Frame& F, const float* X1) {
    const float* g2 = F.in[21]; const float* wrt = F.in[22]; bf16* H2 = (bf16*)(F.ws + WS_H2); float* PROBS = (float*)(F.ws + WS_PROBS);
    LAS float* WR = (LAS float*)F.lds;
    __syncthreads();
    for (int i = F.tid; i < 1024 * 16 / 4; i += NTHR) ((LAS f32x4*)WR)[i] = ((const f32x4*)wrt)[i];
    __syncthreads();
    const int gw = F.bid * NWAVES + F.wave, NGW = F.G * NWAVES, lane = F.lane;
    for (int m = gw; m < NTOK; m += NGW) {
        f32x4 v[4]; rms_row(X1 + (size_t)m * 1024, g2, lane, v); store_row_bf16(H2 + (size_t)m * 1024, lane, v);
        float lg[16];
#pragma unroll
        for (int e = 0; e < 16; ++e) lg[e] = 0.f;
#pragma unroll
        for (int j = 0; j < 4; ++j)
#pragma unroll
            for (int q = 0; q < 4; ++q) { const int d = 4 * lane + 256 * j + q; const float hv = v[j][q];
#pragma unroll
                for (int e4 = 0; e4 < 4; ++e4) { const f32x4 w4 = *(const LAS f32x4*)(WR + d * 16 + e4 * 4); lg[e4 * 4 + 0] += hv * w4.x; lg[e4 * 4 + 1] += hv * w4.y; lg[e4 * 4 + 2] += hv * w4.z; lg[e4 * 4 + 3] += hv * w4.w; }
                if (q & 1) asm volatile("" ::: "memory"); }
        float mx = -3.0e38f;
#pragma unroll
        for (int e = 0; e < 16; ++e) { lg[e] = wave_sum(lg[e]); mx = fmaxf(mx, lg[e]); }
        float den = 0.f;
#pragma unroll
        for (int e = 0; e < 16; ++e) { lg[e] = expf(lg[e] - mx); den += lg[e]; }
        const float inv = 1.f / den; float mine = 0.f;
#pragma unroll
        for (int e = 0; e < 16; ++e) mine = (lane == e) ? lg[e] * inv : mine;
        if (lane < 16) PROBS[((size_t)(m >> 12) * 16 + lane) * SEQ + (m & (SEQ - 1))] = mine;
    }
}

__device__ __forceinline__ int block_excl_scan(int v, LAS int* tmp, int tid, int lane, int wave, int& total) {
    int inc = v;
#pragma unroll
    for (int o = 1; o < 64; o <<= 1) { const int t = __shfl_up(inc, o); if (lane >= o) inc += t; }
    __syncthreads();
    if (lane == 63) tmp[wave] = inc;
    __syncthreads();
    int base = 0, tot = 0;
#pragma unroll
    for (int w = 0; w < 8; ++w) { const int t = tmp[w]; tot += t; if (w < wave) base += t; }
    total = tot; return base + inc - v;
}
__device__ __forceinline__ void p10_topk(const Frame& F) {
    const float* PROBS = (const float*)(F.ws + WS_PROBS); int* IDX = (int*)(F.ws + WS_IDX); float* GATEV = (float*)(F.ws + WS_GATEV); int* SEL = (int*)(F.ws + WS_SEL);
    LAS int* red = (LAS int*)F.lds;
    const int tid = F.tid, lane = F.lane, wave = F.wave;
    for (int pair = F.bid; pair < 256; pair += F.G) {
        const int e = pair >> 4, b = pair & 15;
        const float* src = PROBS + ((size_t)b * 16 + e) * SEQ + tid * 8;
        const f32x4 p0 = *(const f32x4*)src, p1 = *(const f32x4*)(src + 4);
        float vals[8] = {p0.x, p0.y, p0.z, p0.w, p1.x, p1.y, p1.z, p1.w};
        unsigned key[8];
#pragma unroll
        for (int i = 0; i < 8; ++i) key[i] = __builtin_bit_cast(unsigned, vals[i]);
        unsigned tau = 0u;
        __syncthreads();
        for (int bit = 30; bit >= 0; --bit) {
            const unsigned cand = tau | (1u << bit); int cnt = 0;
#pragma unroll
            for (int i = 0; i < 8; ++i) cnt += __popcll(__ballot(key[i] >= cand));
            LAS int* r = red + (bit & 1) * 8;
            if (lane == 0) r[wave] = cnt;
            __syncthreads();
            int tot = 0;
#pragma unroll
            for (int w = 0; w < 8; ++w) tot += r[w];
            if (tot >= CAP) tau = cand;
        }
        int gtc = 0, eqc = 0;
#pragma unroll
        for (int i = 0; i < 8; ++i) { gtc += key[i] > tau ? 1 : 0; eqc += key[i] == tau ? 1 : 0; }
        int n_gt, n_eq;
        (void)block_excl_scan(gtc, red + 16, tid, lane, wave, n_gt);
        const int eq_before = block_excl_scan(eqc, red + 16, tid, lane, wave, n_eq);
        const int need_eq = CAP - n_gt;
        int selc = 0, er = eq_before; bool sel[8];
#pragma unroll
        for (int i = 0; i < 8; ++i) { bool s = key[i] > tau; if (key[i] == tau) { s = er < need_eq; ++er; } sel[i] = s; selc += s ? 1 : 0; }
        int n_sel; int slot = block_excl_scan(selc, red + 16, tid, lane, wave, n_sel);
#pragma unroll
        for (int i = 0; i < 8; ++i) { const int l = tid * 8 + i, tok = b * SEQ + l;
            if (sel[i]) { IDX[(e * NB + b) * CAP + slot] = tok; GATEV[(e * NB + b) * CAP + slot] = vals[i]; SEL[(size_t)tok * 16 + e] = slot; ++slot; }
            else SEL[(size_t)tok * 16 + e] = -1; }
        __syncthreads();
    }
}

__device__ __forceinline__ void p13_final(const Frame& F, float* X1) {
    const float* fg = F.in[26]; const bf16* YS = (const bf16*)(F.ws + WS_YS); const int* SEL = (const int*)(F.ws + WS_SEL);
    const int gw = F.bid * NWAVES + F.wave, NGW = F.G * NWAVES, lane = F.lane;
    for (int m = gw; m < NTOK; m += NGW) {
        float* xrow = X1 + (size_t)m * 1024; f32x4 v[4];
#pragma unroll
        for (int j = 0; j < 4; ++j) v[j] = ((const f32x4*)xrow)[lane + 64 * j];
        const int b = m >> 12; const int myslot = (lane < 16) ? SEL[(size_t)m * 16 + lane] : -1;
        for (int e = 0; e < 16; ++e) {
            const int sl = __shfl(myslot, e);
            if (sl >= 0) { const bf16* yr = YS + ((size_t)e * (NB * CAP) + b * CAP + sl) * 1024;
#pragma unroll
                for (int j = 0; j < 4; ++j) { const u32x2 w = ((const u32x2*)yr)[lane + 64 * j]; v[j].x += bflo(w.x); v[j].y += bfhi(w.x); v[j].z += bflo(w.y); v[j].w += bfhi(w.y); } }
        }
        float s = 0.f;
#pragma unroll
        for (int j = 0; j < 4; ++j) s += (v[j].x * v[j].x + v[j].y * v[j].y) + (v[j].z * v[j].z + v[j].w * v[j].w);
        const float r = 1.f / sqrtf(wave_sum(s) * (1.f / 1024.f) + EPS);
#pragma unroll
        for (int j = 0; j < 4; ++j) { const f32x4 gv = ((const f32x4*)fg)[lane + 64 * j]; ((f32x4*)xrow)[lane + 64 * j] = v[j] * r * gv; }
    }
}

constexpr int NPHASE = 13;
__global__ void __launch_bounds__(NTHR, 2) fwd_kernel(Args args) {
    extern __shared__ __attribute__((aligned(16))) unsigned char lds_raw[];
    Frame F; F.lds = (LAS unsigned char*)lds_raw; F.tid = threadIdx.x; F.lane = F.tid & 63; F.wave = __builtin_amdgcn_readfirstlane(F.tid >> 6);
    F.G = gridDim.x; F.bid = blockIdx.x; F.ws = args.ws; F.in = args.in;
    const int lo = args.ph_lo, hi = args.ph_hi;
    unsigned char* ws = args.ws; float* X1 = args.out;
#ifndef PHASE_MASK
#define PHASE_MASK 0x1FFF
#endif
#define IN(k) (((PHASE_MASK >> (k)) & 1) && lo <= (k) && (k) < hi)
#define SEAM(k) do { if (IN(k) && IN((k) + 1)) { cg::this_grid().sync(); } } while (0)
    using namespace pg8;
    if (IN(0)) { p0_s5_tables(F); p0_weights(F); p1_rmsnorm(F); }
    SEAM(0);
    if (IN(1)) { DenseSched S; S.T.init(NTOK / 256, PT / 256, 1, F.G, F.bid); S.A = (const char*)(ws + WS_H1); S.B = (const char*)(ws + WS_WIN_T); S.a_grp = 0; S.b_grp = 0; S.lda = 1024; S.K = 1024;
        EpiWin E{(bf16*)(ws + WS_UV), (bf16*)(ws + WS_ACOMB), (bf16*)(ws + WS_GATES), args.in[3]}; gemm_phase(F.lds, S, E); }
    SEAM(1);
    if (IN(2)) { p3_gmlp(F); __syncthreads();
        DenseSched S; S.T.init(NCHUNK / 256, 1, 16, F.G, F.bid); S.A = (const char*)(ws + WS_ACOMB); S.B = (const char*)(ws + WS_BCO); S.a_grp = (size_t)NCHUNK * 512 * 2; S.b_grp = (size_t)256 * 256 * 2; S.lda = 512; S.K = 256;
        EpiCarry E{(float*)(ws + WS_SLOC)}; gemm_phase(F.lds, S, E); }
    SEAM(2);
    if (IN(3)) { p4_scan(F); }
    SEAM(3);
    if (IN(4)) { DenseSched S; S.T.init(NCHUNK / 256, 1, 16, F.G, F.bid); S.A = (const char*)(ws + WS_ACOMB); S.B = (const char*)(ws + WS_BMAIN); S.a_grp = (size_t)NCHUNK * 512 * 2; S.b_grp = (size_t)256 * 512 * 2; S.lda = 512; S.K = 512;
        EpiS5 E{(bf16*)(ws + WS_Y)}; gemm_phase(F.lds, S, E); }
    SEAM(4);
    if (IN(5)) { DenseSched S; S.T.init(NTOK / 256, 1, 1, F.G, F.bid); S.A = (const char*)(ws + WS_Y); S.B = (const char*)(ws + WS_WGLU_T); S.a_grp = 0; S.b_grp = 0; S.lda = 256; S.K = 256;
        EpiGlu E{(const bf16*)(ws + WS_Y), (bf16*)(ws + WS_BRB), args.in[17]}; gemm_phase(F.lds, S, E); }
    SEAM(5);
    if (IN(6)) {
        { DenseSched S; S.T.init(NTOK / 256, 4, 1, F.G, F.bid); S.A = (const char*)(ws + WS_BRA); S.B = (const char*)(ws + WS_WUPA_T); S.a_grp = 0; S.b_grp = 0; S.lda = 512; S.K = 512;
          EpiUp<false> E{(bf16*)(ws + WS_MERGED), (const bf16*)(ws + WS_GATES), 0}; gemm_phase(F.lds, S, E); }
#ifndef DIAG_SKIP_UPB
        { DenseSched S; S.T.init(NTOK / 256, 4, 1, F.G, F.bid); S.A = (const char*)(ws + WS_BRB); S.B = (const char*)(ws + WS_WUPB_T); S.a_grp = 0; S.b_grp = 0; S.lda = 256; S.K = 256;
          EpiUp<true> E{(bf16*)(ws + WS_MERGED), (const bf16*)(ws + WS_GATES), 1024}; gemm_phase(F.lds, S, E); }
#endif
    }
    SEAM(6);
    if (IN(7)) { DenseSched S; S.T.init(NTOK / 256, 4, 1, F.G, F.bid); S.A = (const char*)(ws + WS_MERGED); S.B = (const char*)(ws + WS_WOUT_T); S.a_grp = 0; S.b_grp = 0; S.lda = 1024; S.K = 1024;
        EpiOut E{args.in[0], X1}; gemm_phase(F.lds, S, E); }
    SEAM(7);
    if (IN(8)) { p9_norm_router(F, X1); }
    SEAM(8);
    if (IN(9)) { p10_topk(F); }
    SEAM(9);
    if (IN(10)) { GatherSched S; S.T.init((NB * CAP) / 256, (2 * FF) / 256, NE, F.G, F.bid); S.A = (const char*)(ws + WS_H2); S.B = (const char*)(ws + WS_WGU_T); S.b_grp = (size_t)4096 * 1024 * 2; S.idx = (const int*)(ws + WS_IDX); S.rows_per_grp = NB * CAP; S.K = 1024;
        EpiHid E{(bf16*)(ws + WS_HID)}; gemm_phase(F.lds, S, E); }
    SEAM(10);
    if (IN(11)) { DenseSched S; S.T.init((NB * CAP) / 256, DM / 256, NE, F.G, F.bid); S.A = (const char*)(ws + WS_HID); S.B = (const char*)(ws + WS_WD_T); S.a_grp = (size_t)(NB * CAP) * FF * 2; S.b_grp = (size_t)DM * FF * 2; S.lda = FF; S.K = FF;
        EpiDown E{(bf16*)(ws + WS_YS), (const float*)(ws + WS_GATEV)}; gemm_phase(F.lds, S, E); }
    SEAM(11);
    if (IN(12)) { p13_final(F, X1); }
#undef IN
#undef SEAM
}


__global__ void dump_bf16(const unsigned short* src, float* out, size_t n) {
    for (size_t i = (size_t)blockIdx.x * blockDim.x + threadIdx.x; i < n; i += (size_t)gridDim.x * blockDim.x) out[i] = __builtin_bit_cast(float, (unsigned)src[i] << 16);
}
__global__ void dump_f32(const float* src, float* out, size_t n) {
    for (size_t i = (size_t)blockIdx.x * blockDim.x + threadIdx.x; i < n; i += (size_t)gridDim.x * blockDim.x) out[i] = src[i];
}
#ifndef DIAG_DUMP_OFF
#define DIAG_DUMP_OFF WS_GATES
#endif
#ifndef DIAG_DUMP_N
#define DIAG_DUMP_N ((size_t)NTOK * 1024)
#endif
#ifndef DIAG_DUMP_F32
#define DIAG_DUMP_F32 0
#endif
extern "C" void kernel_launch(void* const* d_in, const int* in_sizes, int n_in, void* d_out, int out_size, void* d_ws, size_t ws_size, hipStream_t stream) {
    static int grid = 0;
    if (grid == 0) {
        if (n_in != 27 || out_size != NTOK * DM || ws_size < WS_END) { fprintf(stderr, "kernel_launch: unexpected shapes: n_in %d out %d ws %zu (need >= %zu)\n", n_in, out_size, ws_size, (size_t)WS_END); grid = -1; return; }
        int dev = 0, cus = 0, per_cu = 0;
        if (hipGetDevice(&dev) != hipSuccess || hipDeviceGetAttribute(&cus, hipDeviceAttributeMultiprocessorCount, dev) != hipSuccess) { grid = -1; return; }
        if (hipFuncSetAttribute((const void*)fwd_kernel, hipFuncAttributeMaxDynamicSharedMemorySize, LDS_BYTES) != hipSuccess) { fprintf(stderr, "kernel_launch: hipFuncSetAttribute failed\n"); grid = -1; return; }
        if (hipOccupancyMaxActiveBlocksPerMultiprocessor(&per_cu, (const void*)fwd_kernel, NTHR, LDS_BYTES) != hipSuccess || per_cu < 1) { fprintf(stderr, "kernel_launch: occupancy query says %d\n", per_cu); per_cu = 1; }
        (void)hipGetLastError();
        grid = cus;
    }
    if (grid < 0) return;
#ifdef DIAG_MEMSET
    (void)hipMemsetAsync(d_ws, 0, WS_END, stream); (void)hipMemsetAsync(d_out, 0, (size_t)NTOK * DM * 4, stream);
#endif
    Args a{};
    for (int i = 0; i < 27; ++i) a.in[i] = (const float*)d_in[i];
    a.out = (float*)d_out; a.ws = (unsigned char*)d_ws;
#if MK_ONE_LAUNCH
    a.ph_lo = 0; a.ph_hi = NPHASE;
    void* kargs[] = {&a};
    hipError_t e = hipLaunchCooperativeKernel((const void*)fwd_kernel, dim3(grid), dim3(NTHR), kargs, LDS_BYTES, stream);
    if (e != hipSuccess) fprintf(stderr, "kernel_launch: cooperative launch failed: %s (grid %d)\n", hipGetErrorString(e), grid);
#else
    for (int p = 0; p < DIAG_NPH; ++p) { a.ph_lo = p; a.ph_hi = p + 1; hipLaunchKernelGGL(fwd_kernel, dim3(grid), dim3(NTHR), LDS_BYTES, stream, a); }
    if (DIAG_NPH < 8) { if (DIAG_DUMP_F32) hipLaunchKernelGGL(dump_f32, dim3(2048), dim3(256), 0, stream, (const float*)((char*)d_ws + DIAG_DUMP_OFF), (float*)d_out, DIAG_DUMP_N);
        else hipLaunchKernelGGL(dump_bf16, dim3(2048), dim3(256), 0, stream, (const unsigned short*)((char*)d_ws + DIAG_DUMP_OFF), (float*)d_out, DIAG_DUMP_N); }
#endif
}
```

```cpp
#include <hip/hip_runtime.h>
#include <cstdio>
#include <cstdint>

#ifndef MK_ONE_LAUNCH
#define MK_ONE_LAUNCH 1
#endif

#define GAS __attribute__((address_space(1)))
#define LAS __attribute__((address_space(3)))
typedef unsigned short bf16;
typedef short bf16x8 __attribute__((ext_vector_type(8)));
typedef float f32x4 __attribute__((ext_vector_type(4)));
typedef float f32x2 __attribute__((ext_vector_type(2)));
typedef unsigned u32x4 __attribute__((ext_vector_type(4)));
typedef unsigned u32x2 __attribute__((ext_vector_type(2)));

constexpr int NB = 16, SEQ = 4096, DM = 1024, NTOK = NB * SEQ;
constexpr int PT = 3328;
constexpr int NE = 16, CAP = 512, FF = 2048;
constexpr int TCH = 16, NCHUNK = NTOK / TCH, CPS = SEQ / TCH;
constexpr float EPS = 1e-6f;
constexpr int NWAVES = 8, NTHR = 512;

constexpr size_t MiB = 1u << 20;
constexpr size_t WS_WIN_T = 1 * MiB;
constexpr size_t WS_WS = 8 * MiB;
constexpr size_t WS_WGLU_T = 8 * MiB + 512 * 1024;
constexpr size_t WS_WUPAB_T = 9 * MiB;
constexpr size_t WS_WOUT_T = 11 * MiB;
constexpr size_t WS_LT = 13 * MiB;
constexpr size_t WS_KT = 22 * MiB;
constexpr size_t WS_BCO = 14 * MiB;
constexpr size_t WS_BMAIN = 16 * MiB;
constexpr size_t WS_WG8 = 20 * MiB;
constexpr size_t WS_H1F8 = 96 * MiB;
constexpr size_t WS_WGU_T = 32 * MiB;
constexpr size_t WS_WD_T = 160 * MiB;
constexpr size_t WS_H1 = 224 * MiB;
constexpr size_t WS_MERGED = 736 * MiB;
constexpr size_t WS_RINV = 24 * MiB;
constexpr size_t WS_UV = 352 * MiB;
constexpr size_t WS_GATES = 480 * MiB;
constexpr size_t WS_HID = 480 * MiB;
constexpr size_t WS_X1B = 352 * MiB;
constexpr size_t WS_ACOMB = 736 * MiB;
constexpr size_t WS_SLOC = 800 * MiB;
constexpr size_t WS_BRAB = 864 * MiB;
constexpr size_t WS_Y = 960 * MiB;
constexpr size_t WS_H2 = 736 * MiB;
constexpr size_t WS_YS = 736 * MiB;
constexpr size_t WS_PROBS = 992 * MiB;
constexpr size_t WS_IDX = 996 * MiB;
constexpr size_t WS_GATEV = 997 * MiB;
constexpr size_t WS_TOKS = 997 * MiB + 512 * 1024;
constexpr size_t WS_SEL = 998 * MiB;
constexpr size_t WS_END = 1024 * MiB;

constexpr int LDS_BYTES = 147456;

typedef __bf16 bf16x2_t __attribute__((ext_vector_type(2)));
__device__ __forceinline__ unsigned cvt_pk_bf16(float lo, float hi) { f32x2 v = {lo, hi}; return __builtin_bit_cast(unsigned, __builtin_convertvector(v, bf16x2_t)); }
__device__ __forceinline__ unsigned f2bf(float f) { return (unsigned)__builtin_bit_cast(unsigned short, (__bf16)f); }
__device__ __forceinline__ unsigned pk2(float lo, float hi) { return cvt_pk_bf16(lo, hi); }
__device__ __forceinline__ unsigned pk4_fp8(float a, float b, float c, float d) { unsigned w = 0u; w = __builtin_amdgcn_cvt_pk_fp8_f32(a, b, w, false); w = __builtin_amdgcn_cvt_pk_fp8_f32(c, d, w, true); return w; }
__device__ __forceinline__ float bflo(unsigned w) { return __builtin_bit_cast(float, w << 16); }
__device__ __forceinline__ float bfhi(unsigned w) { return __builtin_bit_cast(float, w & 0xffff0000u); }
__device__ __forceinline__ float wave_sum(float v) {
#pragma unroll
    for (int o = 1; o < 64; o <<= 1) v += __shfl_xor(v, o);
    return v;
}
__device__ __forceinline__ float sigmoid_f(float x) { return __builtin_amdgcn_rcpf(1.0f + __builtin_amdgcn_exp2f(-1.4426950408889634f * x)); }
__device__ __forceinline__ f32x2 gelu_pk(f32x2 v) {
    const f32x2 av = __builtin_elementwise_abs(v), d = av * 0.2316418882f + 1.0f;
    f32x2 t; t.x = __builtin_amdgcn_rcpf(d.x); t.y = __builtin_amdgcn_rcpf(d.y);
    f32x2 q = t * 0.5307027145f + (-0.7265760135f); q = q * t + 0.7107068705f; q = q * t + (-0.142248368f); q = q * t + 0.127414796f; q = q * t;
    const f32x2 s = (v * v) * (-0.72134752044f);
    f32x2 e; e.x = __builtin_amdgcn_exp2f(s.x); e.y = __builtin_amdgcn_exp2f(s.y);
    const f32x2 m = v * (q * e), r = v - m;
    f32x2 o; o.x = v.x < 0.f ? m.x : r.x; o.y = v.y < 0.f ? m.y : r.y; return o;
}
__device__ __forceinline__ f32x4 gelu4(f32x4 v) { f32x2 a = gelu_pk((f32x2){v[0], v[1]}), b = gelu_pk((f32x2){v[2], v[3]}); return (f32x4){a.x, a.y, b.x, b.y}; }
__device__ __forceinline__ u32x4 pack8(f32x4 v0, f32x4 v1) { u32x4 w; w.x = cvt_pk_bf16(v0[0], v0[1]); w.y = cvt_pk_bf16(v0[2], v0[3]); w.z = cvt_pk_bf16(v1[0], v1[1]); w.w = cvt_pk_bf16(v1[2], v1[3]); return w; }

namespace pg8 {
constexpr int BM = 256, BK = 64, HALF = 128, HTB = HALF * BK * 2, STAGE_BYTES = 8 * HTB, NXCD = 8, WGM = 8;
__host__ __device__ __forceinline__ int lds_byte(int r, int c) { const int st = (r >> 4) * 2 + (c >> 5), rr = r & 15, cc = c & 31, ob = rr * 64 + cc * 2; return st * 1024 + (ob ^ (((ob >> 9) & 1) << 5)); }
__host__ __device__ __forceinline__ void stage_rc(int b, int& R, int& C) { const int st = b / 1024, sb = b % 1024, swz = sb ^ (((sb >> 9) & 1) << 5); R = (st >> 1) * 16 + swz / 64; C = (st & 1) * 32 + (swz % 64) / 2; }
__host__ __device__ __forceinline__ int perm32(int rho) { const int n = rho >> 4, i = rho & 15; return 8 * (i >> 2) + 4 * n + (i & 3); }

struct Unit { unsigned A, B; int pm, pn, grp; };

struct TileOrder {
    int nM, nN, upg, total, G, c, rev;
    __device__ __forceinline__ void init(int nM_, int nN_, int ngrp, int G_, int c_) { nM = nM_; nN = nN_; upg = nM * nN; total = upg * ngrp; G = G_; c = c_; rev = 0; }
    __device__ __forceinline__ bool tile(int i, int& grp, int& pm, int& pn) const {
        const int L = i * G + c; if (L >= total) return false;
        grp = L / upg; int wgid = L - grp * upg;
        { const int nwg = upg, q = nwg / NXCD, r = nwg % NXCD, xcd = wgid % NXCD, off = wgid / NXCD; wgid = (xcd < r ? xcd * (q + 1) : r * (q + 1) + (xcd - r) * q) + off; }
        const int nig = WGM * nN, gid = wgid / nig, fm = gid * WGM, gsz = (nM - fm) < WGM ? (nM - fm) : WGM;
        pm = fm + ((wgid % nig) % gsz); pn = (wgid % nig) / gsz; if (rev) pm = nM - 1 - pm; return true;
    }
};
struct DenseSched {
    static constexpr bool GATHER = false;
    __device__ __forceinline__ const int* rows(const Unit&) const { return nullptr; }
    __device__ __forceinline__ const int* table() const { return nullptr; }
    TileOrder T; const char* A; const char* B; size_t a_grp, b_grp; int lda, K;
    __device__ __forceinline__ bool next(int i, Unit& u) const {
        int g, pm, pn; if (!T.tile(i, g, pm, pn)) return false;
        u.pm = pm; u.pn = pn; u.grp = g; u.A = (unsigned)((size_t)g * a_grp + (size_t)pm * BM * lda); u.B = (unsigned)((size_t)g * b_grp + (size_t)pn * BM * K); return true;
    }
};
struct GatherSched {
    static constexpr bool GATHER = true;
    TileOrder T; const char* A; const char* B; const int* toks; size_t b_grp; int rows_grp, lda, K;
    __device__ __forceinline__ bool next(int i, Unit& u) const {
        int g, pm, pn; if (!T.tile(i, g, pm, pn)) return false;
        u.pm = pm; u.pn = pn; u.grp = g; u.A = 0u; u.B = (unsigned)((size_t)g * b_grp + (size_t)pn * BM * K); return true;
    }
    __device__ __forceinline__ const int* rows(const Unit& u) const { return toks + u.grp * rows_grp + u.pm * BM; }
    __device__ __forceinline__ const int* table() const { return toks; }
};
__host__ __device__ __forceinline__ int f8_swz(int fr) { const int h = fr >> 1, sw = ((h & 1) << 1) | ((h >> 1) & 1); return (h & 4) | (sw ^ (h >> 2)); }
typedef int v8i32 __attribute__((ext_vector_type(8)));
typedef int v4i32 __attribute__((ext_vector_type(4)));
template <class E, class = void> struct EpiHook { static constexpr int T = 0; template <class A, class U> static __device__ __forceinline__ void run(const E&, A&, const U&, int, int, int, int) {} };
template <class E> struct EpiHook<E, decltype((void)E::HOOK_T)> { static constexpr int T = E::HOOK_T; template <class A, class U> static __device__ __forceinline__ void run(const E& e, A& acc, const U& u, int wr, int wc, int fr, int fq) { e.mid(acc, u, wr, wc, fr, fq); } };
template <class Epi, class Sched, bool F8 = false>
__device__ __forceinline__ void gemm_phase(LAS unsigned char* lds, const Sched& S, const Epi& E) {
    const int tid = threadIdx.x, wid = __builtin_amdgcn_readfirstlane(tid >> 6), lane = tid & 63, wr = wid >> 2, wc = wid & 3, fr = lane & 15, fq = lane >> 4;
    const int K = S.K, nt = K / 128;
    int R0, C0;
    if (F8) { R0 = tid >> 3; C0 = ((tid & 7) ^ f8_swz(R0 & 15)) * 16; }
    else { int c; stage_rc(tid * 16, R0, c); C0 = c * 2; }
    const int Rb = Epi::PERM ? ((R0 & ~31) + perm32(R0 & 31)) : R0;
    const unsigned vB = (unsigned)(Rb * K + C0), vA = (unsigned)(R0 * S.lda + C0);
    const unsigned kstep = 128u, hstepB = (unsigned)(HALF * K), qstepB = (unsigned)(64 * K), hstepA = (unsigned)(HALF * S.lda), qstepA = (unsigned)(64 * S.lda);
    const __amdgpu_buffer_rsrc_t srdA = __builtin_amdgcn_make_buffer_rsrc((void*)S.A, 0, -16, 0x00020000), srdB = __builtin_amdgcn_make_buffer_rsrc((void*)S.B, 0, -16, 0x00020000);
    const unsigned ldsw = (unsigned)wid * 1024u;
    const int aoff = F8 ? (wr * 64 + fr) * 128 + (((2 * fq) ^ f8_swz(fr)) << 4) : lds_byte(wr * 64 + fr, fq * 8), boff = F8 ? (wc * 32 + fr) * 128 + (((2 * fq) ^ f8_swz(fr)) << 4) : lds_byte(wc * 32 + fr, fq * 8);
    const int aoff1 = F8 ? (aoff ^ 16) : aoff + 1024, boff1 = F8 ? (boff ^ 16) : boff + 1024;
#define PG8_SA(b, h) (((b) * 2 + (h)) * HTB)
#define PG8_SB(b, h) ((4 + (b) * 2 + (h)) * HTB)
#define PG8_STAGE2(srd, bufoff, voff, soff, qstep) do { \
        __builtin_amdgcn_raw_ptr_buffer_load_lds(srd, (LAS void*)(lds + (bufoff) + ldsw), 16, (int)(voff), (int)(soff), 0, 0); \
        __builtin_amdgcn_raw_ptr_buffer_load_lds(srd, (LAS void*)(lds + (bufoff) + ldsw + 8192), 16, (int)(voff), (int)((soff) + (qstep)), 0, 0); } while (0)
#define PG8_STAGEAG(b, h, soff, par) do { if (Sched::GATHER) { \
        const LAS int* tp_ = (const LAS int*)(lds + 131072 + (par) * 1024 + tabA + (h) * 512); const unsigned o0_ = ((unsigned)tp_[0] << 10) + gC0, o1_ = ((unsigned)tp_[64] << 10) + gC0; \
        __builtin_amdgcn_raw_ptr_buffer_load_lds(srdA, (LAS void*)(lds + PG8_SA(b, h) + ldsw), 16, (int)o0_, (int)(soff), 0, 0); \
        __builtin_amdgcn_raw_ptr_buffer_load_lds(srdA, (LAS void*)(lds + PG8_SA(b, h) + ldsw + 8192), 16, (int)o1_, (int)(soff), 0, 0); } \
        else PG8_STAGE2(srdA, PG8_SA(b, h), vA, (soff) + (h) * hstepA, qstepA); } while (0)
#define PG8_STAGEA(b, h, soff) PG8_STAGEAG(b, h, soff, ui & 1)
#define PG8_STAGEB(b, h, soff) PG8_STAGE2(srdB, PG8_SB(b, h), vB, (soff) + (h) * hstepB, qstepB)
#define PG8_LDA(dst, b, h) do { _Pragma("unroll") for (int m = 0; m < 4; ++m) { \
        if (F8) { const v4i32 lo_ = *(const LAS v4i32*)(lds + PG8_SA(b, h) + aoff + m * 2048), hi_ = *(const LAS v4i32*)(lds + PG8_SA(b, h) + aoff1 + m * 2048); dst##8[m] = __builtin_shufflevector(lo_, hi_, 0, 1, 2, 3, 4, 5, 6, 7); } \
        else { dst[m][0] = *(const LAS bf16x8*)(lds + PG8_SA(b, h) + aoff + m * 2048); dst[m][1] = *(const LAS bf16x8*)(lds + PG8_SA(b, h) + aoff1 + m * 2048); } } } while (0)
#define PG8_LDB(dst, b, h) do { _Pragma("unroll") for (int n = 0; n < 2; ++n) { \
        if (F8) { const v4i32 lo_ = *(const LAS v4i32*)(lds + PG8_SB(b, h) + boff + n * 2048), hi_ = *(const LAS v4i32*)(lds + PG8_SB(b, h) + boff1 + n * 2048); dst##8[n] = __builtin_shufflevector(lo_, hi_, 0, 1, 2, 3, 4, 5, 6, 7); } \
        else { dst[n][0] = *(const LAS bf16x8*)(lds + PG8_SB(b, h) + boff + n * 2048); dst[n][1] = *(const LAS bf16x8*)(lds + PG8_SB(b, h) + boff1 + n * 2048); } } } while (0)
#define PG8_MMA(ai, bj, At, Bt) do { __builtin_amdgcn_s_setprio(1); _Pragma("unroll") for (int m = 0; m < 4; ++m) _Pragma("unroll") for (int n = 0; n < 2; ++n) { \
        if (F8) acc[ai][bj][m][n] = __builtin_amdgcn_mfma_scale_f32_16x16x128_f8f6f4(Bt##8[n], At##8[m], acc[ai][bj][m][n], 0, 0, 0, 0, 0, 0);     \
        else { _Pragma("unroll") for (int k = 0; k < 2; ++k) acc[ai][bj][m][n] = __builtin_amdgcn_mfma_f32_16x16x32_bf16(Bt[n][k], At[m][k], acc[ai][bj][m][n], 0, 0, 0); } } \
        __builtin_amdgcn_s_setprio(0); } while (0)
#define PG8_WAIT_V(n) asm volatile("s_waitcnt vmcnt(" #n ")" ::: "memory")
#define PG8_WAIT_L(n) asm volatile("s_waitcnt lgkmcnt(" #n ")" ::: "memory")
#define PG8_BAR __builtin_amdgcn_s_barrier()
#define PG8_SCHED __builtin_amdgcn_sched_barrier(0)
    Unit cur, nxt; int ui = 0;
    if (!S.next(0, cur)) return;
    f32x4 acc[2][2][4][2];
#pragma unroll
    for (int a = 0; a < 2; ++a)
#pragma unroll
        for (int b = 0; b < 2; ++b)
#pragma unroll
            for (int m = 0; m < 4; ++m)
#pragma unroll
                for (int n = 0; n < 2; ++n) acc[a][b][m][n] = (f32x4){0.f, 0.f, 0.f, 0.f};
    bf16x8 At[4][2], B0[2][2], B1[2][2]; v8i32 At8[4], B08[2], B18[2];
    unsigned cA = cur.A, cB = cur.B;
    const unsigned gC0 = (unsigned)C0, tabA = (unsigned)R0 * 4u;
    const __amdgpu_buffer_rsrc_t srdT = __builtin_amdgcn_make_buffer_rsrc((void*)S.table(), 0, -16, 0x00020000);
    const int* rows0 = S.table();
#define PG8_TAB(par, u_) do { if (wid < 4) __builtin_amdgcn_raw_ptr_buffer_load_lds(srdT, (LAS void*)(lds + 131072 + (par) * 1024 + wid * 256), 4, (int)(lane * 4), (int)((S.rows(u_) - rows0) * 4 + wid * 256), 0, 0); } while (0)
    if (Sched::GATHER) { PG8_TAB(0, cur); PG8_WAIT_V(0); PG8_BAR; }
    PG8_STAGEB(0, 0, cB); PG8_STAGEB(0, 1, cB); PG8_STAGEA(0, 0, cA); PG8_STAGEA(0, 1, cA);
    if (wr == 1) PG8_BAR;
    PG8_WAIT_V(2); PG8_BAR;
    PG8_STAGEB(1, 0, cB + kstep); PG8_STAGEB(1, 1, cB + kstep);
    PG8_WAIT_V(4); PG8_BAR;
    for (;;) {
        const bool has_next = S.next(ui + 1, nxt);
        const unsigned nA = has_next ? nxt.A : cA, nB = has_next ? nxt.B : cB;
#pragma clang loop unroll(disable)
        for (int t = 0; t < nt; t += 2) {
            const bool last = (t == nt - 2);
            if (Sched::GATHER && has_next && t == 0) PG8_TAB((ui + 1) & 1, nxt);
            const unsigned a1 = cA + (unsigned)(t + 1) * kstep;
            const unsigned a2 = last ? nA : cA + (unsigned)(t + 2) * kstep, b2 = last ? nB : cB + (unsigned)(t + 2) * kstep;
            const unsigned a3 = a2 + kstep, b3 = b2 + kstep;
            PG8_LDB(B0, 0, 0); PG8_LDB(B1, 0, 1); PG8_SCHED; PG8_LDA(At, 0, 0); PG8_STAGEA(1, 0, a1); PG8_STAGEA(1, 1, a1);
            PG8_WAIT_V(8); PG8_WAIT_L(0); PG8_BAR; PG8_MMA(0, 0, At, B0); PG8_MMA(0, 1, At, B1); PG8_BAR; PG8_SCHED;
            PG8_LDA(At, 0, 1); PG8_STAGEB(0, 0, b2); PG8_STAGEB(0, 1, b2);
            PG8_WAIT_V(6); PG8_WAIT_L(0); PG8_BAR; PG8_MMA(1, 0, At, B0); PG8_MMA(1, 1, At, B1); PG8_BAR; PG8_SCHED;
            PG8_LDB(B0, 1, 0); PG8_LDB(B1, 1, 1); PG8_SCHED; PG8_LDA(At, 1, 0); PG8_STAGEAG(0, 0, a2, (ui + ((last && has_next) ? 1 : 0)) & 1); PG8_STAGEAG(0, 1, a2, (ui + ((last && has_next) ? 1 : 0)) & 1);
            PG8_WAIT_V(8); PG8_WAIT_L(0); PG8_BAR; PG8_MMA(0, 0, At, B0); PG8_MMA(0, 1, At, B1); PG8_BAR; PG8_SCHED;
            PG8_LDA(At, 1, 1); PG8_STAGEB(1, 0, b3); PG8_STAGEB(1, 1, b3);
            PG8_WAIT_V(6); PG8_WAIT_L(0); PG8_BAR; PG8_MMA(1, 0, At, B0); PG8_MMA(1, 1, At, B1); PG8_BAR; PG8_SCHED;
            if (EpiHook<Epi>::T > 0 && t + 2 == EpiHook<Epi>::T) EpiHook<Epi>::run(E, acc, cur, wr, wc, fr, fq);
        }
        if (wr == 0) PG8_BAR;
        E(acc, cur, wr, wc, fr, fq);
        if (!has_next) break;
#pragma unroll
        for (int a = 0; a < 2; ++a)
#pragma unroll
            for (int b = 0; b < 2; ++b)
#pragma unroll
                for (int m = 0; m < 4; ++m)
#pragma unroll
                    for (int n = 0; n < 2; ++n) { double z0, z1; asm volatile("v_mov_b64 %0, 0" : "=v"(z0)); asm volatile("v_mov_b64 %0, 0" : "=v"(z1));
                        const f32x2 lo = __builtin_bit_cast(f32x2, z0), hi = __builtin_bit_cast(f32x2, z1); acc[a][b][m][n] = (f32x4){lo.x, lo.y, hi.x, hi.y}; }
        cur = nxt; cA = nA; cB = nB; ++ui;
        if (wr == 1) PG8_BAR;
    }
    PG8_WAIT_V(0);
    PG8_BAR;
#undef PG8_TAB
#undef PG8_SA
#undef PG8_SB
#undef PG8_STAGE2
#undef PG8_STAGEA
#undef PG8_STAGEAG
#undef PG8_STAGEB
#undef PG8_LDA
#undef PG8_LDB
#undef PG8_MMA
#undef PG8_WAIT_V
#undef PG8_WAIT_L
#undef PG8_BAR
#undef PG8_SCHED
}

#define EPI_LOOP_ROWS for (int ai = 0; ai < 2; ++ai) _Pragma("unroll") for (int m = 0; m < 4; ++m)
struct EpiWin {
    static constexpr bool PERM = true;
    bf16* UV; bf16* ACOMB;
    __device__ __forceinline__ void operator()(const f32x4 (&acc)[2][2][4][2], const Unit& u, int wr, int wc, int fr, int fq) const {
        const int row0 = u.pm * BM + wr * 64 + fr, cw = wc * 32 + 8 * fq;
        if (u.pn < 4) {
#pragma unroll
            EPI_LOOP_ROWS { bf16* rowp = UV + (size_t)(row0 + ai * HALF + m * 16) * 1024 + u.pn * BM + cw;
#pragma unroll
                for (int bj = 0; bj < 2; ++bj) *(u32x4*)(rowp + bj * HALF) = pack8(gelu4(acc[ai][bj][m][0]), gelu4(acc[ai][bj][m][1])); }
        } else {
#pragma unroll
            EPI_LOOP_ROWS { const int row = row0 + ai * HALF + m * 16, chunk = row >> 4, j = row & 15;
#pragma unroll
                for (int bj = 0; bj < 2; ++bj) { const int c = bj * HALF + cw, g = c >> 4, h0 = c & 15;
                    *(u32x4*)(ACOMB + ((size_t)g * NCHUNK + chunk) * 512 + j * 16 + h0) = pack8(acc[ai][bj][m][0], acc[ai][bj][m][1]); } }
        }
    }
};
struct EpiGate {
    static constexpr bool PERM = true;
    bf16* GATES; const float* b_gate;
    __device__ __forceinline__ void operator()(const f32x4 (&acc)[2][2][4][2], const Unit& u, int wr, int wc, int fr, int fq) const {
        const int gc0 = u.pn * HALF + wc * 32 + 8 * fq;
        constexpr float NL2E = -1.4426950408889634f, CS = NL2E * 0.0625f;
        f32x2 pa[4], pb[4];
#pragma unroll
        for (int j = 0; j < 4; ++j) { pa[j] = (f32x2){b_gate[gc0 + 2 * j], b_gate[gc0 + 2 * j + 1]} * NL2E; pb[j] = (f32x2){b_gate[1024 + gc0 + 2 * j], b_gate[1024 + gc0 + 2 * j + 1]} * NL2E; }
        const size_t gidx = ((size_t)u.pm * 8 + u.pn) * 4096 + ((wr * 4 + wc) * 64 + fq * 16 + fr);
        u32x4* rbase = (u32x4*)GATES + gidx; u32x2* qbase = (u32x2*)((char*)GATES + 128 * MiB) + gidx;
#pragma unroll
        EPI_LOOP_ROWS {
            u32x2 qw; qw.x = 0u; qw.y = 0u; u32x4 rw;
#pragma unroll
            for (int j = 0; j < 4; ++j) {
                const f32x4 ap = acc[ai][0][m][j >> 1], ag = acc[ai][1][m][j >> 1];
                const f32x2 p2 = (j & 1) ? (f32x2){ap[2], ap[3]} : (f32x2){ap[0], ap[1]}, g2 = (j & 1) ? (f32x2){ag[2], ag[3]} : (f32x2){ag[0], ag[1]};
                const f32x2 tp = p2 * CS + pa[j], tg = g2 * CS + pb[j];
                f32x2 dp, dg; dp.x = __builtin_amdgcn_exp2f(tp.x); dp.y = __builtin_amdgcn_exp2f(tp.y); dg.x = __builtin_amdgcn_exp2f(tg.x); dg.y = __builtin_amdgcn_exp2f(tg.y);
                dp = dp + 1.0f; dg = dg + 1.0f;
                f32x2 qf; qf.x = __builtin_amdgcn_rcpf(dg.x); qf.y = __builtin_amdgcn_rcpf(dg.y); qf = qf * 255.0f + 0.5f;
                qf.x = fmaxf(qf.x, 1.0f); qf.y = fmaxf(qf.y, 1.0f);
                unsigned qd = (j < 2) ? qw.x : qw.y;
                qd = __builtin_amdgcn_cvt_pk_u8_f32(qf.x, (2 * j) & 3, qd); qd = __builtin_amdgcn_cvt_pk_u8_f32(qf.y, (2 * j + 1) & 3, qd);
                if (j < 2) qw.x = qd; else qw.y = qd;
                f32x2 qs; qs.x = (float)((qd >> (8 * ((2 * j) & 3))) & 0xffu); qs.y = (float)((qd >> (8 * ((2 * j + 1) & 3))) & 0xffu);
                const f32x2 den = qs * dp; f32x2 r2; r2.x = __builtin_amdgcn_rcpf(den.x); r2.y = __builtin_amdgcn_rcpf(den.y); r2 = r2 * 255.0f;
                const unsigned rp = cvt_pk_bf16(r2.x, r2.y);
                if (j == 0) rw.x = rp; else if (j == 1) rw.y = rp; else if (j == 2) rw.z = rp; else rw.w = rp; }
            rbase[ai * 2048 + m * 512] = rw; qbase[ai * 2048 + m * 512] = qw; }
    }
};
struct EpiCarry {
    static constexpr bool PERM = false;
    float* SLOC;
    __device__ __forceinline__ void operator()(const f32x4 (&acc)[2][2][4][2], const Unit& u, int wr, int wc, int fr, int fq) const {
        const int row0 = u.pm * BM + wr * 64 + fr, col0 = wc * 32 + 4 * fq;
#pragma unroll
        EPI_LOOP_ROWS { float* rowp = SLOC + ((size_t)u.grp * NCHUNK + row0 + ai * HALF + m * 16) * 256 + col0;
#pragma unroll
            for (int bj = 0; bj < 2; ++bj)
#pragma unroll
                for (int n = 0; n < 2; ++n) *(f32x4*)(rowp + bj * HALF + n * 16) = acc[ai][bj][m][n]; }
    }
};
struct EpiS5 {
    static constexpr bool PERM = true;
    bf16* Y;
    __device__ __forceinline__ void operator()(const f32x4 (&acc)[2][2][4][2], const Unit& u, int wr, int wc, int fr, int fq) const {
        const int row0 = u.pm * BM + wr * 64 + fr, cw = wc * 32 + 8 * fq;
#pragma unroll
        EPI_LOOP_ROWS { const int chunk = row0 + ai * HALF + m * 16;
#pragma unroll
            for (int bj = 0; bj < 2; ++bj) { const int c = bj * HALF + cw, i = c >> 4, h0 = c & 15;
                *(u32x4*)(Y + ((size_t)chunk * TCH + i) * 256 + u.grp * 16 + h0) = pack8(gelu4(acc[ai][bj][m][0]), gelu4(acc[ai][bj][m][1])); } }
    }
};
struct EpiGlu {
    static constexpr bool PERM = true;
    const bf16* Y; bf16* BRB; const float* b_glu;
    __device__ __forceinline__ void operator()(const f32x4 (&acc)[2][2][4][2], const Unit& u, int wr, int wc, int fr, int fq) const {
        const int row0 = u.pm * BM + wr * 64 + fr, cw = wc * 32 + 8 * fq;
        f32x4 bv[2][2];
#pragma unroll
        for (int bj = 0; bj < 2; ++bj)
#pragma unroll
            for (int n = 0; n < 2; ++n) bv[bj][n] = *(const f32x4*)(b_glu + cw + bj * HALF + 4 * n);
#pragma unroll
        for (int ai = 0; ai < 2; ++ai) {
            u32x4 yv[4][2];
#pragma unroll
            for (int m = 0; m < 4; ++m)
#pragma unroll
                for (int bj = 0; bj < 2; ++bj) yv[m][bj] = *(const u32x4*)(Y + (size_t)(row0 + ai * HALF + m * 16) * 256 + cw + bj * HALF);
#pragma unroll
            for (int m = 0; m < 4; ++m)
#pragma unroll
                for (int bj = 0; bj < 2; ++bj) { const u32x4 y = yv[m][bj];
                    f32x4 v0 = acc[ai][bj][m][0] + bv[bj][0], v1 = acc[ai][bj][m][1] + bv[bj][1];
                    v0[0] = bflo(y.x) * sigmoid_f(v0[0]); v0[1] = bfhi(y.x) * sigmoid_f(v0[1]); v0[2] = bflo(y.y) * sigmoid_f(v0[2]); v0[3] = bfhi(y.y) * sigmoid_f(v0[3]);
                    v1[0] = bflo(y.z) * sigmoid_f(v1[0]); v1[1] = bfhi(y.z) * sigmoid_f(v1[1]); v1[2] = bflo(y.w) * sigmoid_f(v1[2]); v1[3] = bfhi(y.w) * sigmoid_f(v1[3]);
                    *(u32x4*)(BRB + (size_t)(row0 + ai * HALF + m * 16) * 768 + 512 + cw + bj * HALF) = pack8(v0, v1); }
            asm volatile("" ::: "memory");
        }
    }
};
struct EpiMerged {
    static constexpr bool PERM = true; static constexpr int HOOK_T = 8;
    bf16* MERGED; const bf16* GATES;
    static __device__ __forceinline__ void mul8(f32x4& v0, f32x4& v1, const u32x4 g, const bool clamp, const bool inv) {
        float f[8] = {bflo(g.x), bfhi(g.x), bflo(g.y), bfhi(g.y), bflo(g.z), bfhi(g.z), bflo(g.w), bfhi(g.w)};
#pragma unroll
        for (int j = 0; j < 8; ++j) { if (clamp) f[j] = fmaxf(f[j], 1e-6f); if (inv) f[j] = __builtin_amdgcn_rcpf(f[j]); }
        v0 = v0 * (f32x4){f[0], f[1], f[2], f[3]}; v1 = v1 * (f32x4){f[4], f[5], f[6], f[7]};
    }
    __device__ __forceinline__ void mid(f32x4 (&acc)[2][2][4][2], const Unit& u, int wr, int wc, int fr, int fq) const {
        const u32x4* gbase = (const u32x4*)GATES + ((size_t)u.pm * 8 + 2 * u.pn) * 4096 + ((wr * 4 + wc) * 64 + fq * 16 + fr);
#pragma unroll
        for (int ai = 0; ai < 2; ++ai) {
            u32x4 gr[4][2];
#pragma unroll
            for (int m = 0; m < 4; ++m)
#pragma unroll
                for (int bj = 0; bj < 2; ++bj) gr[m][bj] = gbase[bj * 4096 + ai * 2048 + m * 512];
#pragma unroll
            for (int m = 0; m < 4; ++m)
#pragma unroll
                for (int bj = 0; bj < 2; ++bj) mul8(acc[ai][bj][m][0], acc[ai][bj][m][1], gr[m][bj], false, false);
            asm volatile("" ::: "memory");
        }
    }
    __device__ __forceinline__ void operator()(const f32x4 (&acc)[2][2][4][2], const Unit& u, int wr, int wc, int fr, int fq) const {
        const int row0 = u.pm * BM + wr * 64 + fr, col0 = u.pn * BM + wc * 32 + 8 * fq;
        const u32x2* qbase = (const u32x2*)((const char*)GATES + 128 * MiB) + ((size_t)u.pm * 8 + 2 * u.pn) * 4096 + ((wr * 4 + wc) * 64 + fq * 16 + fr);
#pragma unroll
        for (int ai = 0; ai < 2; ++ai) {
            u32x2 gb[4][2];
#pragma unroll
            for (int m = 0; m < 4; ++m)
#pragma unroll
                for (int bj = 0; bj < 2; ++bj) gb[m][bj] = qbase[bj * 4096 + ai * 2048 + m * 512];
#pragma unroll
            for (int m = 0; m < 4; ++m)
#pragma unroll
                for (int bj = 0; bj < 2; ++bj) { const u32x2 q = gb[m][bj];
                    const f32x4 s0 = (f32x4){(float)((q.x >> 0) & 0xffu), (float)((q.x >> 8) & 0xffu), (float)((q.x >> 16) & 0xffu), (float)((q.x >> 24) & 0xffu)} * (1.f / 255.f);
                    const f32x4 s1 = (f32x4){(float)((q.y >> 0) & 0xffu), (float)((q.y >> 8) & 0xffu), (float)((q.y >> 16) & 0xffu), (float)((q.y >> 24) & 0xffu)} * (1.f / 255.f);
                    *(u32x4*)(MERGED + (size_t)(row0 + ai * HALF + m * 16) * 1024 + col0 + bj * HALF) = pack8(acc[ai][bj][m][0] * s0, acc[ai][bj][m][1] * s1); }
            asm volatile("" ::: "memory");
        }
    }
};
struct EpiOut {
    static constexpr bool PERM = true;
    const bf16* H1; const float* RINV; const float* G1; bf16* X1B;
    __device__ __forceinline__ void operator()(const f32x4 (&acc)[2][2][4][2], const Unit& u, int wr, int wc, int fr, int fq) const {
        const int row0 = u.pm * BM + wr * 64 + fr, col0 = u.pn * BM + wc * 32 + 8 * fq;
        f32x4 gi[2][2];
#pragma unroll
        for (int bj = 0; bj < 2; ++bj)
#pragma unroll
            for (int n = 0; n < 2; ++n) { const f32x4 gv = *(const f32x4*)(G1 + col0 + bj * HALF + 4 * n); gi[bj][n] = (f32x4){1.f / gv.x, 1.f / gv.y, 1.f / gv.z, 1.f / gv.w}; }
#pragma unroll
        for (int ai = 0; ai < 2; ++ai) {
            u32x4 hv[4][2]; float ri[4];
#pragma unroll
            for (int m = 0; m < 4; ++m) { ri[m] = RINV[row0 + ai * HALF + m * 16];
#pragma unroll
                for (int bj = 0; bj < 2; ++bj) hv[m][bj] = *(const u32x4*)(H1 + (size_t)(row0 + ai * HALF + m * 16) * 1024 + col0 + bj * HALF); }
#pragma unroll
            for (int m = 0; m < 4; ++m)
#pragma unroll
                for (int bj = 0; bj < 2; ++bj) { const u32x4 h = hv[m][bj];
                    const f32x4 x0 = (f32x4){bflo(h.x), bfhi(h.x), bflo(h.y), bfhi(h.y)} * gi[bj][0] * ri[m], x1 = (f32x4){bflo(h.z), bfhi(h.z), bflo(h.w), bfhi(h.w)} * gi[bj][1] * ri[m];
                    *(u32x4*)(X1B + (size_t)(row0 + ai * HALF + m * 16) * 1024 + col0 + bj * HALF) = pack8(x0 + acc[ai][bj][m][0], x1 + acc[ai][bj][m][1]); }
            asm volatile("" ::: "memory");
        }
    }
};
struct EpiHid {
    static constexpr bool PERM = true;
    unsigned char* HID;
    __device__ __forceinline__ void operator()(const f32x4 (&acc)[2][2][4][2], const Unit& u, int wr, int wc, int fr, int fq) const {
        const int row0 = u.pm * BM + wr * 64 + fr, col0 = u.pn * HALF + wc * 32 + 8 * fq;
#pragma unroll
        EPI_LOOP_ROWS { const size_t row = (size_t)u.grp * (NB * CAP) + row0 + ai * HALF + m * 16;
            f32x2 pr[4];
#pragma unroll
            for (int q = 0; q < 4; ++q) { const f32x4 a4 = acc[ai][0][m][q >> 1], u4 = acc[ai][1][m][q >> 1];
                const f32x2 a2 = (q & 1) ? (f32x2){a4[2], a4[3]} : (f32x2){a4[0], a4[1]}, u2 = (q & 1) ? (f32x2){u4[2], u4[3]} : (f32x2){u4[0], u4[1]};
                const f32x2 t2 = a2 * (-0.09016844005556021f); f32x2 e2; e2.x = __builtin_amdgcn_exp2f(t2.x); e2.y = __builtin_amdgcn_exp2f(t2.y);
                const f32x2 d2 = e2 * 256.0f + 256.0f; f32x2 r2; r2.x = __builtin_amdgcn_rcpf(d2.x); r2.y = __builtin_amdgcn_rcpf(d2.y);
                pr[q] = (a2 * u2) * r2; }
            u32x2 o; o.x = pk4_fp8(pr[0].x, pr[0].y, pr[1].x, pr[1].y); o.y = pk4_fp8(pr[2].x, pr[2].y, pr[3].x, pr[3].y); *(u32x2*)(HID + row * FF + col0) = o; }
    }
};
struct EpiDown {
    static constexpr bool PERM = true;
    unsigned char* YS; const float* GATEV;
    __device__ __forceinline__ void operator()(const f32x4 (&acc)[2][2][4][2], const Unit& u, int wr, int wc, int fr, int fq) const {
        const int row0 = u.pm * BM + wr * 64 + fr, col0 = u.pn * BM + wc * 32 + 8 * fq;
#pragma unroll
        EPI_LOOP_ROWS { const size_t row = (size_t)u.grp * (NB * CAP) + row0 + ai * HALF + m * 16; const float gt = GATEV[row] * 0.5f;
#pragma unroll
            for (int bj = 0; bj < 2; ++bj) { const f32x4 v0 = acc[ai][bj][m][0] * gt, v1 = acc[ai][bj][m][1] * gt; u32x2 o; o.x = pk4_fp8(v0[0], v0[1], v0[2], v0[3]); o.y = pk4_fp8(v1[0], v1[1], v1[2], v1[3]); *(u32x2*)(YS + row * 1024 + col0 + bj * HALF) = o; } }
    }
};
}


#define XB_TMO      128
#define XB_XCNT(j)  (256  + 64 * (j))
#define XB_XSUB(j)  (1280 + 64 * (j))
#define XB_XGEN(j)  (2304 + 64 * (j))
#define XB_TOP      3328
#define XB_TOPGEN   3392
#define XCD_BAR_WORDS 3456
#define XB_SPIN_CAP (1u << 20)
__device__ __forceinline__ unsigned xb_ld(unsigned* p)              { return __hip_atomic_load(p, __ATOMIC_RELAXED, __HIP_MEMORY_SCOPE_AGENT); }
__device__ __forceinline__ unsigned xb_add(unsigned* p, unsigned v) { return __hip_atomic_fetch_add(p, v, __ATOMIC_RELAXED, __HIP_MEMORY_SCOPE_AGENT); }
__device__ __forceinline__ unsigned xb_xcc_id() { return (unsigned)__builtin_amdgcn_s_getreg((3 << 11) | 20) & 0xFu; }
#define XB_SPIN(cond, bar) do { unsigned _sp = 0; while (cond) { __builtin_amdgcn_s_sleep(1); \
    if ((++_sp & 255u) == 0u) { if (xb_ld(&(bar)[XB_TMO])) break; if (_sp > XB_SPIN_CAP) { atomicAdd(&(bar)[XB_TMO], 1u); break; } } } } while (0)
struct XcdBarrier { unsigned* bar; unsigned x; volatile LAS unsigned* st; };
__device__ __forceinline__ XcdBarrier xcd_barrier_post(unsigned* bar, volatile LAS unsigned* st) {
    XcdBarrier b; b.bar = bar; b.x = xb_xcc_id(); b.st = st;
    if (threadIdx.x == 0) (void)xb_add(&bar[XB_XCNT(b.x)], 1u);
    return b;
}
__device__ __forceinline__ void xcd_barrier_complete(unsigned* bar, unsigned x, unsigned& nloc, unsigned& nx) {
    const unsigned G = gridDim.x * gridDim.y * gridDim.z;
    unsigned sum, cnt, mine, sp = 0u;
    for (;;) {
        sum = 0u; cnt = 0u; mine = 0u;
#pragma unroll
        for (unsigned j = 0; j < 16; ++j) { const unsigned c = xb_ld(&bar[XB_XCNT(j)]); sum += c; cnt += (c > 0u) ? 1u : 0u; mine = (j == x) ? c : mine; }
        if (sum == G) break;
        __builtin_amdgcn_s_sleep(1);
        if ((++sp & 255u) == 0u) { if (xb_ld(&bar[XB_TMO])) break; if (sp > XB_SPIN_CAP) { atomicAdd(&bar[XB_TMO], 1u); break; } }
    }
    nloc = mine > 0u ? mine : 1u; nx = cnt > 0u ? cnt : 1u;
}
__device__ __forceinline__ void xcd_barrier(const XcdBarrier& b) {
    asm volatile("s_waitcnt vmcnt(0)" ::: "memory");
    __syncthreads();
    if (threadIdx.x == 0) {
        unsigned* bar = b.bar;
        __builtin_amdgcn_s_waitcnt(0);
        unsigned nloc = b.st[0], nx = b.st[1];
        if (nloc == 0u) { xcd_barrier_complete(bar, b.x, nloc, nx); b.st[0] = nloc; b.st[1] = nx; }
        const unsigned old = xb_add(&bar[XB_XSUB(b.x)], 1u);
        const unsigned gen = old / nloc;
        if (old + 1u == (gen + 1u) * nloc) {
            __builtin_amdgcn_fence(__ATOMIC_RELEASE, "agent");
            asm volatile("s_waitcnt vmcnt(0)" ::: "memory");
            const unsigned og = xb_add(&bar[XB_TOP], 1u);
            const unsigned tg = og / nx;
            if (og + 1u == (tg + 1u) * nx) xb_add(&bar[XB_TOPGEN], 1u);
            else XB_SPIN(xb_ld(&bar[XB_TOPGEN]) == tg, bar);
            __builtin_amdgcn_fence(__ATOMIC_ACQUIRE, "agent");
            xb_add(&bar[XB_XGEN(b.x)], 1u);
            asm volatile("s_waitcnt vmcnt(0)" ::: "memory");
        } else {
            XB_SPIN(xb_ld(&bar[XB_XGEN(b.x)]) == gen, bar);
            __builtin_amdgcn_fence(__ATOMIC_ACQUIRE, "agent");
            asm volatile("s_waitcnt vmcnt(0)" ::: "memory");
        }
    }
    __syncthreads();
}

struct Args { const float* in[27]; float* out; unsigned char* ws; int ph_lo, ph_hi; };

struct Frame {
    LAS unsigned char* lds; int tid, lane, wave, G, bid;
    unsigned char* ws; const float* const* in;
};

template <bool F8>
__device__ __forceinline__ void transpose_item(const float* W, int N, void* WTv, int ldt, int k0, int n0, int drow0, float scale, LAS float* scr, int lane, int kd = -1) {
    if (kd < 0) kd = k0;
    float r[64];
#pragma unroll
    for (int i = 0; i < 64; ++i) r[i] = W[(size_t)(k0 + i) * N + n0 + lane];
#pragma unroll
    for (int i = 0; i < 64; ++i) scr[i * 65 + lane] = r[i];
    asm volatile("s_waitcnt lgkmcnt(0)" ::: "memory");
    if (F8) {
        unsigned char* WT = (unsigned char*)WTv;
#pragma unroll
        for (int jj = 0; jj < 4; ++jj) { const int p = lane + 64 * jj, n = p >> 2, c = p & 3; const LAS float* sp = scr + (16 * c) * 65 + n;
            u32x4 o; o.x = pk4_fp8(sp[0] * scale, sp[65] * scale, sp[130] * scale, sp[195] * scale); o.y = pk4_fp8(sp[260] * scale, sp[325] * scale, sp[390] * scale, sp[455] * scale);
            o.z = pk4_fp8(sp[520] * scale, sp[585] * scale, sp[650] * scale, sp[715] * scale); o.w = pk4_fp8(sp[780] * scale, sp[845] * scale, sp[910] * scale, sp[975] * scale);
            *(u32x4*)(WT + (size_t)(drow0 + n) * ldt + kd + 16 * c) = o; }
    } else {
        bf16* WT = (bf16*)WTv;
#pragma unroll
        for (int jj = 0; jj < 8; ++jj) { const int p = lane + 64 * jj, n = p >> 3, c = p & 7; const LAS float* sp = scr + (8 * c) * 65 + n;
            u32x4 o; o.x = pk2(sp[0], sp[65]); o.y = pk2(sp[130], sp[195]); o.z = pk2(sp[260], sp[325]); o.w = pk2(sp[390], sp[455]);
            *(u32x4*)(WT + (size_t)(drow0 + n) * ldt + kd + 8 * c) = o; }
    }
    asm volatile("s_waitcnt lgkmcnt(0)" ::: "memory");
}

__device__ __forceinline__ void p0_s5_tables(const Frame& F) {
    const float* lam_re = F.in[8]; const float* lam_im = F.in[9]; const float* log_dt = F.in[10];
    const float* b_re = F.in[11]; const float* b_im = F.in[12]; const float* c_re = F.in[13]; const float* c_im = F.in[14];
    bf16* BMAIN = (bf16*)(F.ws + WS_BMAIN); bf16* BCO = (bf16*)(F.ws + WS_BCO); float* LT = (float*)(F.ws + WS_LT); float* KT = (float*)(F.ws + WS_KT);
    LAS float* PW = (LAS float*)F.lds;
    LAS float* BB = PW + 2 * 17 * 64 * 2;
    for (int wg = F.bid; wg < 256; wg += F.G) {
        const int g = wg >> 4, sl = wg & 15, tid = F.tid;
        __syncthreads();
        if (tid < 128) {
            const int dir = tid >> 6, p = tid & 63, li = (dir * 16 + g) * 64 + p;
            const float lr = lam_re[li], lim = lam_im[li], dt = expf(log_dt[dir * 16 + g]);
            float l1r, l1i, k_re, k_im;
            {
                const float mag = expf(lr * dt); double rev = (double)lim * (double)dt * 0.15915494309189535; rev -= rint(rev);
                const float ang = (float)(rev * 6.283185307179586), cs = cosf(ang), sn = sinf(ang); l1r = mag * cs; l1i = mag * sn;
                const float sh = sinf(0.5f * ang); const float nr = expm1f(lr * dt) * cs - 2.f * sh * sh, ni = mag * sn;
                const float den = 1.f / (lr * lr + lim * lim); k_re = (nr * lr + ni * lim) * den; k_im = (ni * lr - nr * lim) * den;
            }
            float pr = 1.f, pi = 0.f;
            for (int d = 0; d <= 16; ++d) { PW[((dir * 17 + d) * 64 + p) * 2 + 0] = pr; PW[((dir * 17 + d) * 64 + p) * 2 + 1] = pi; const float nr = pr * l1r - pi * l1i, ni = pr * l1i + pi * l1r; pr = nr; pi = ni; }
            for (int h = 0; h < 16; ++h) { const float br = b_re[li * 16 + h], bi = b_im[li * 16 + h];
                BB[((dir * 64 + p) * 16 + h) * 2 + 0] = k_re * br - k_im * bi; BB[((dir * 64 + p) * 16 + h) * 2 + 1] = k_re * bi + k_im * br; }
            if (sl == 0) {
                const float mag = expf(lr * dt * 16.f); double rev = (double)lim * (double)dt * 16.0 * 0.15915494309189535; rev -= rint(rev);
                const float ang = (float)(rev * 6.283185307179586); LT[li * 2 + 0] = mag * cosf(ang); LT[li * 2 + 1] = mag * sinf(ang); }
        }
        __syncthreads();
        {
            const int dir = tid >> 8, h = (tid >> 4) & 15, hp = tid & 15, d = sl; float s_ = 0.f;
            const float* cr = c_re + ((dir * 16 + g) * 16 + h) * 64; const float* ci = c_im + ((dir * 16 + g) * 16 + h) * 64;
            for (int p = 0; p < 64; ++p) { const float wr_ = PW[((dir * 17 + d) * 64 + p) * 2], wi_ = PW[((dir * 17 + d) * 64 + p) * 2 + 1], br = BB[((dir * 64 + p) * 16 + hp) * 2], bi = BB[((dir * 64 + p) * 16 + hp) * 2 + 1];
                const float zr = wr_ * br - wi_ * bi, zi = wr_ * bi + wi_ * br; s_ += cr[p] * zr - ci[p] * zi; }
            KT[(((g * 2 + dir) * 16 + d) * 16 + h) * 16 + hp] = s_;
        }
        const int i = sl;
        for (int mm = 0; mm < 8; ++mm) {
            const int e = tid + 512 * mm, h = e >> 8, q = e & 255, dir = q >> 7, im = (q >> 6) & 1, p = q & 63, d = dir == 0 ? i + 1 : 16 - i;
            const float cr = c_re[((dir * 16 + g) * 16 + h) * 64 + p], ci = c_im[((dir * 16 + g) * 16 + h) * 64 + p], wr_ = PW[((dir * 17 + d) * 64 + p) * 2], wi_ = PW[((dir * 17 + d) * 64 + p) * 2 + 1];
            BMAIN[((size_t)g * 256 + i * 16 + h) * 512 + 256 + q] = (bf16)f2bf(im ? -(cr * wi_ + ci * wr_) : (cr * wr_ - ci * wi_));
        }
        for (int mm = 0; mm < 8; ++mm) {
            const int e = tid + 512 * mm, ql = e >> 8, k = e & 255, q = sl * 16 + ql, dir = q >> 7, im = (q >> 6) & 1, p = q & 63, j = k >> 4, hp = k & 15, d = dir == 0 ? 15 - j : j;
            const float wr_ = PW[((dir * 17 + d) * 64 + p) * 2], wi_ = PW[((dir * 17 + d) * 64 + p) * 2 + 1], br = BB[((dir * 64 + p) * 16 + hp) * 2], bi = BB[((dir * 64 + p) * 16 + hp) * 2 + 1];
            BCO[((size_t)g * 256 + q) * 256 + k] = (bf16)f2bf(im ? (wr_ * bi + wi_ * br) : (wr_ * br - wi_ * bi));
        }
    }
    __syncthreads();
}
__device__ __forceinline__ void s5_assemble_bmain(const Frame& F) {
    bf16* BMAIN = (bf16*)(F.ws + WS_BMAIN); const float* KT = (const float*)(F.ws + WS_KT); const float* d_skip = F.in[15];
    for (int wg = F.bid; wg < 256; wg += F.G) {
        const int g = wg >> 4, i = wg & 15;
        for (int mm = 0; mm < 8; ++mm) {
            const int e = F.tid + 512 * mm, h = e >> 8, k = e & 255, j = k >> 4, hp = k & 15; float val;
            if (j < i) val = KT[(((g * 2 + 0) * 16 + (i - j)) * 16 + h) * 16 + hp];
            else if (j > i) val = KT[(((g * 2 + 1) * 16 + (j - i)) * 16 + h) * 16 + hp];
            else val = KT[(((g * 2 + 0) * 16 + 0) * 16 + h) * 16 + hp] + KT[(((g * 2 + 1) * 16 + 0) * 16 + h) * 16 + hp] + (h == hp ? d_skip[g * 16 + h] : 0.f);
            BMAIN[((size_t)g * 256 + i * 16 + h) * 512 + k] = (bf16)f2bf(val);
        }
    }
}

__device__ __forceinline__ void p0_weights(const Frame& F) {
    LAS float* scr = (LAS float*)(F.lds + F.wave * 16640);
    const int gw = F.bid * NWAVES + F.wave, NGW = F.G * NWAVES, lane = F.lane;
    bf16* WIN_T = (bf16*)(F.ws + WS_WIN_T); bf16* WUPAB_T = (bf16*)(F.ws + WS_WUPAB_T); bf16* WOUT_T = (bf16*)(F.ws + WS_WOUT_T);
    bf16* WGLU_T = (bf16*)(F.ws + WS_WGLU_T); unsigned char* WG8 = (unsigned char*)(F.ws + WS_WG8); unsigned char* WGU8 = (unsigned char*)(F.ws + WS_WGU_T); unsigned char* WD8 = (unsigned char*)(F.ws + WS_WD_T); bf16* WSB = (bf16*)(F.ws + WS_WS);
    constexpr int I_IN = 16 * 52, I_UA = 8 * 16, I_UB = 4 * 16, I_OUT = 16 * 16, I_GLU = 4 * 4, I_G = 16 * 512, I_D = 16 * 512;
    constexpr int NITEMS = I_IN + I_UA + I_UB + I_OUT + I_GLU + 2 * I_G + I_D;
    for (int it = gw; it < NITEMS; it += NGW) {
        int r = it;
        if (r < I_IN) { const int kb = r / 52, nb = r % 52;
            if (nb < 20) transpose_item<false>(F.in[2], PT, WIN_T, 1024, kb * 64, nb * 64, nb * 64, 1.f, scr, lane);
            else { const int c = nb * 64 - 1280, isb = c >> 10, cc = c & 1023; transpose_item<true>(F.in[2], PT, WG8, 1024, kb * 64, nb * 64, (cc >> 7) * 256 + (cc & 127) + isb * 128, 16.f, scr, lane); }
            continue; } r -= I_IN;
        if (r < I_UA) { const int kb = r / 16, nb = r % 16; transpose_item<false>(F.in[18], 1024, WUPAB_T, 768, kb * 64, nb * 64, nb * 64, 1.f, scr, lane); continue; } r -= I_UA;
        if (r < I_UB) { const int kb = r / 16, nb = r % 16; transpose_item<false>(F.in[19], 1024, WUPAB_T, 768, kb * 64, nb * 64, nb * 64, 1.f, scr, lane, 512 + kb * 64); continue; } r -= I_UB;
        if (r < I_OUT) { const int kb = r / 16, nb = r % 16; transpose_item<false>(F.in[20], 1024, WOUT_T, 1024, kb * 64, nb * 64, nb * 64, 1.f, scr, lane); continue; } r -= I_OUT;
        if (r < I_GLU) { const int kb = r / 4, nb = r % 4; transpose_item<false>(F.in[16], 256, WGLU_T, 256, kb * 64, nb * 64, nb * 64, 1.f, scr, lane); continue; } r -= I_GLU;
        if (r < 2 * I_G) { const int up = r >= I_G ? 1 : 0; if (up) r -= I_G; const int e = r >> 9, w = r & 511, kb = w >> 5, nb = w & 31, n0 = nb * 64;
            transpose_item<true>(F.in[up ? 24 : 23] + (size_t)e * 1024 * 2048, 2048, WGU8 + (size_t)e * 4096 * 1024, 1024, kb * 64, n0, (n0 >> 7) * 256 + (n0 & 127) + up * 128, 16.f, scr, lane); continue; } r -= 2 * I_G;
        { const int e = r >> 9, w = r & 511, kb = w >> 4, nb = w & 15; transpose_item<true>(F.in[25] + (size_t)e * 2048 * 1024, 1024, WD8 + (size_t)e * 1024 * 2048, 2048, kb * 64, nb * 64, nb * 64, 32.f, scr, lane); }
    }
    for (int i = F.bid * NTHR + F.tid; i < 8 * 128 * 128; i += F.G * NTHR) WSB[i] = (bf16)f2bf(F.in[6][i]);
}

__device__ __forceinline__ void rms_row(const float* xrow, const float* g, int lane, f32x4 (&v)[4]) {
    const f32x4* xr = (const f32x4*)xrow + lane; float s = 0.f;
#pragma unroll
    for (int j = 0; j < 4; ++j) { v[j] = xr[64 * j]; s += (v[j].x * v[j].x + v[j].y * v[j].y) + (v[j].z * v[j].z + v[j].w * v[j].w); }
    const float r = 1.f / sqrtf(wave_sum(s) * (1.f / 1024.f) + EPS);
#pragma unroll
    for (int j = 0; j < 4; ++j) { const f32x4 gv = ((const f32x4*)g)[lane + 64 * j]; v[j] = v[j] * r * gv; }
}
__device__ __forceinline__ void store_row_bf16(bf16* orow, int lane, const f32x4 (&v)[4]) {
    u32x2* o8 = (u32x2*)orow + lane;
#pragma unroll
    for (int j = 0; j < 4; ++j) { u32x2 w; w.x = pk2(v[j].x, v[j].y); w.y = pk2(v[j].z, v[j].w); o8[64 * j] = w; }
}

__device__ __forceinline__ void store_row_fp8(unsigned char* orow, int lane, const f32x4 (&v)[4]) {
    unsigned* o4 = (unsigned*)orow + lane;
#pragma unroll
    for (int j = 0; j < 4; ++j) o4[64 * j] = pk4_fp8(v[j].x, v[j].y, v[j].z, v[j].w);
}
template <int R>
__device__ __forceinline__ void load_rows(const float* x0, size_t rstride, int lane, f32x4 (&v)[R][4]) {
#pragma unroll
    for (int r = 0; r < R; ++r)
#pragma unroll
        for (int j = 0; j < 4; ++j) v[r][j] = ((const f32x4*)(x0 + r * rstride))[lane + 64 * j];
}
template <int R>
__device__ __forceinline__ void load_rows_bf16(const bf16* x0, int lane, f32x4 (&v)[R][4]) {
    u32x2 w[R][4];
#pragma unroll
    for (int r = 0; r < R; ++r)
#pragma unroll
        for (int j = 0; j < 4; ++j) w[r][j] = ((const u32x2*)(x0 + (size_t)r * 1024))[lane + 64 * j];
#pragma unroll
    for (int r = 0; r < R; ++r)
#pragma unroll
        for (int j = 0; j < 4; ++j) v[r][j] = (f32x4){bflo(w[r][j].x), bfhi(w[r][j].x), bflo(w[r][j].y), bfhi(w[r][j].y)};
}
template <int R>
__device__ __forceinline__ void load_rows_bf16_raw(const bf16* x0, int lane, u32x2 (&w)[R][4]) {
#pragma unroll
    for (int r = 0; r < R; ++r)
#pragma unroll
        for (int j = 0; j < 4; ++j) w[r][j] = ((const u32x2*)(x0 + (size_t)r * 1024))[lane + 64 * j];
}
template <int R>
__device__ __forceinline__ void rows_from_raw(const u32x2 (&w)[R][4], f32x4 (&v)[R][4]) {
#pragma unroll
    for (int r = 0; r < R; ++r)
#pragma unroll
        for (int j = 0; j < 4; ++j) v[r][j] = (f32x4){bflo(w[r][j].x), bfhi(w[r][j].x), bflo(w[r][j].y), bfhi(w[r][j].y)};
}
template <int R>
__device__ __forceinline__ void rms_scale_rows(const float* g, int lane, f32x4 (&v)[R][4], float* rms_out = nullptr) {
    float s[R];
#pragma unroll
    for (int r = 0; r < R; ++r) { s[r] = 0.f;
#pragma unroll
        for (int j = 0; j < 4; ++j) s[r] += (v[r][j].x * v[r][j].x + v[r][j].y * v[r][j].y) + (v[r][j].z * v[r][j].z + v[r][j].w * v[r][j].w); }
#pragma unroll
    for (int o = 1; o < 64; o <<= 1)
#pragma unroll
        for (int r = 0; r < R; ++r) s[r] += __shfl_xor(s[r], o);
#pragma unroll
    for (int j = 0; j < 4; ++j) { const f32x4 gv = ((const f32x4*)g)[lane + 64 * j];
#pragma unroll
        for (int r = 0; r < R; ++r) { const float rr = 1.f / sqrtf(s[r] * (1.f / 1024.f) + EPS); v[r][j] = v[r][j] * rr * gv; } }
    if (rms_out) {
#pragma unroll
        for (int r = 0; r < R; ++r) if (lane == r) rms_out[r] = sqrtf(s[r] * (1.f / 1024.f) + EPS); }
}
__device__ __forceinline__ void p1_rmsnorm(const Frame& F) {
    const float* x = F.in[0]; const float* g = F.in[1]; bf16* H1 = (bf16*)(F.ws + WS_H1); unsigned char* H1F8 = (unsigned char*)(F.ws + WS_H1F8);
    const int gw = F.bid * NWAVES + F.wave, NGW = F.G * NWAVES;
    f32x4 vn[4][4]; if (gw * 4 < NTOK) load_rows<4>(x + (size_t)(gw * 4) * 1024, 1024, F.lane, vn);
    for (int m = gw * 4; m < NTOK; m += NGW * 4) {
        f32x4 v[4][4];
#pragma unroll
        for (int r = 0; r < 4; ++r)
#pragma unroll
            for (int j = 0; j < 4; ++j) v[r][j] = vn[r][j];
        if (m + NGW * 4 < NTOK) load_rows<4>(x + (size_t)(m + NGW * 4) * 1024, 1024, F.lane, vn);
        rms_scale_rows<4>(g, F.lane, v, (float*)(F.ws + WS_RINV) + m);
#pragma unroll
        for (int r = 0; r < 4; ++r) { store_row_bf16(H1 + (size_t)(m + r) * 1024, F.lane, v[r]); store_row_fp8(H1F8 + (size_t)(m + r) * 1024, F.lane, v[r]); }
    }
}

__device__ __forceinline__ void p3_gmlp(const Frame& F) {
    const bf16* UV = (const bf16*)(F.ws + WS_UV); const bf16* WSB = (const bf16*)(F.ws + WS_WS); bf16* BRA = (bf16*)(F.ws + WS_BRAB);
    const float* ln_g = F.in[4]; const float* ln_b = F.in[5]; const float* b_s = F.in[7];
    LAS unsigned char* vnT = F.lds;
    const int lane = F.lane, w = F.wave;
    f32x4 lg0 = *(const f32x4*)(ln_g + lane * 8), lg1 = *(const f32x4*)(ln_g + lane * 8 + 4), lb0 = *(const f32x4*)(ln_b + lane * 8), lb1 = *(const f32x4*)(ln_b + lane * 8 + 4);
    const float lgv[8] = {lg0.x, lg0.y, lg0.z, lg0.w, lg1.x, lg1.y, lg1.z, lg1.w}, lbv[8] = {lb0.x, lb0.y, lb0.z, lb0.w, lb1.x, lb1.y, lb1.z, lb1.w};
    for (int chunk = F.bid; chunk < NTOK / 128; chunk += F.G) {
        const size_t tok0 = (size_t)chunk * 128;
        __syncthreads();
#pragma unroll 1
        for (int hf = 0; hf < 2; ++hf) {
            u32x4 raw[8];
#pragma unroll
            for (int tt = 0; tt < 8; ++tt) raw[tt] = *(const u32x4*)(UV + (tok0 + w * 16 + hf * 8 + tt) * 1024 + 512 + lane * 8);
            float mean[8], rstd[8];
#pragma unroll
            for (int tt = 0; tt < 8; ++tt) { const u32x4 r = raw[tt]; mean[tt] = ((bflo(r.x) + bfhi(r.x)) + (bflo(r.y) + bfhi(r.y))) + ((bflo(r.z) + bfhi(r.z)) + (bflo(r.w) + bfhi(r.w))); }
#pragma unroll
            for (int o = 1; o < 64; o <<= 1)
#pragma unroll
                for (int tt = 0; tt < 8; ++tt) mean[tt] += __shfl_xor(mean[tt], o);
#pragma unroll
            for (int tt = 0; tt < 8; ++tt) { mean[tt] *= (1.f / 512.f); const u32x4 r = raw[tt]; const float m_ = mean[tt];
                const float d0 = bflo(r.x) - m_, d1 = bfhi(r.x) - m_, d2 = bflo(r.y) - m_, d3 = bfhi(r.y) - m_, d4 = bflo(r.z) - m_, d5 = bfhi(r.z) - m_, d6 = bflo(r.w) - m_, d7 = bfhi(r.w) - m_;
                rstd[tt] = ((d0 * d0 + d1 * d1) + (d2 * d2 + d3 * d3)) + ((d4 * d4 + d5 * d5) + (d6 * d6 + d7 * d7)); }
#pragma unroll
            for (int o = 1; o < 64; o <<= 1)
#pragma unroll
                for (int tt = 0; tt < 8; ++tt) rstd[tt] += __shfl_xor(rstd[tt], o);
#pragma unroll
            for (int tt = 0; tt < 8; ++tt) rstd[tt] = 1.f / sqrtf(rstd[tt] * (1.f / 512.f) + EPS);
#pragma unroll
            for (int e = 0; e < 8; ++e) {
                unsigned pk[4];
#pragma unroll
                for (int t2 = 0; t2 < 4; ++t2) {
                    const unsigned wa = (e >> 1) == 0 ? raw[2 * t2].x : (e >> 1) == 1 ? raw[2 * t2].y : (e >> 1) == 2 ? raw[2 * t2].z : raw[2 * t2].w;
                    const unsigned wb = (e >> 1) == 0 ? raw[2 * t2 + 1].x : (e >> 1) == 1 ? raw[2 * t2 + 1].y : (e >> 1) == 2 ? raw[2 * t2 + 1].z : raw[2 * t2 + 1].w;
                    const float fa = (e & 1) ? bfhi(wa) : bflo(wa), fb = (e & 1) ? bfhi(wb) : bflo(wb);
                    pk[t2] = pk2((fa - mean[2 * t2]) * rstd[2 * t2] * lgv[e] + lbv[e], (fb - mean[2 * t2 + 1]) * rstd[2 * t2 + 1] * lgv[e] + lbv[e]); }
                *(LAS u32x4*)(vnT + (lane * 8 + e) * 272 + w * 32 + hf * 16) = (u32x4){pk[0], pk[1], pk[2], pk[3]}; }
        }
        __syncthreads();
        const int t = w * 16 + (lane & 15), kq = (lane >> 4) * 8, t2 = lane >> 2, part = lane & 3;
        bf16x8 wf[4];
#pragma unroll
        for (int kk = 0; kk < 4; ++kk) wf[kk] = *(const bf16x8*)(WSB + ((size_t)0 * 128 + t) * 128 + kk * 32 + kq);
#pragma unroll
        for (int g = 0; g < 8; ++g) {
            bf16x8 wn[4];
            const bf16* up = UV + (tok0 + w * 16 + t2) * 1024 + g * 64 + part * 16;
            const u32x4 ua = *(const u32x4*)up, ub = *(const u32x4*)(up + 8);
            if (g < 7) {
#pragma unroll
                for (int kk = 0; kk < 4; ++kk) wn[kk] = *(const bf16x8*)(WSB + ((size_t)(g + 1) * 128 + t) * 128 + kk * 32 + kq); }
            const float bs = b_s[g * 128 + t];
            f32x4 acc[4];
#pragma unroll
            for (int ct = 0; ct < 4; ++ct) acc[ct] = (f32x4){0.f, 0.f, 0.f, 0.f};
#pragma unroll
            for (int kk = 0; kk < 4; ++kk)
#pragma unroll
                for (int ct = 0; ct < 4; ++ct) { const bf16x8 vf = *(const LAS bf16x8*)(vnT + (g * 64 + ct * 16 + (lane & 15)) * 272 + (kk * 32 + kq) * 2);
                    acc[ct] = __builtin_amdgcn_mfma_f32_16x16x32_bf16(vf, wf[kk], acc[ct], 0, 0, 0); }
            __syncthreads();
            LAS unsigned char* stg = vnT + g * 64 * 272 + w * 2176;
#pragma unroll
            for (int ct = 0; ct < 4; ++ct) { u32x2 zz; zz.x = pk2(acc[ct][0] + bs, acc[ct][1] + bs); zz.y = pk2(acc[ct][2] + bs, acc[ct][3] + bs);
                *(LAS u32x2*)(stg + (lane & 15) * 136 + ct * 32 + (lane >> 4) * 8) = zz; }
            u32x2 zr[4];
#pragma unroll
            for (int k = 0; k < 4; ++k) zr[k] = *(const LAS u32x2*)(stg + t2 * 136 + part * 32 + k * 8);
            u32x4 oa, ob;
            oa.x = pk2(bflo(ua.x) * bflo(zr[0].x), bfhi(ua.x) * bfhi(zr[0].x)); oa.y = pk2(bflo(ua.y) * bflo(zr[0].y), bfhi(ua.y) * bfhi(zr[0].y));
            oa.z = pk2(bflo(ua.z) * bflo(zr[1].x), bfhi(ua.z) * bfhi(zr[1].x)); oa.w = pk2(bflo(ua.w) * bflo(zr[1].y), bfhi(ua.w) * bfhi(zr[1].y));
            ob.x = pk2(bflo(ub.x) * bflo(zr[2].x), bfhi(ub.x) * bfhi(zr[2].x)); ob.y = pk2(bflo(ub.y) * bflo(zr[2].y), bfhi(ub.y) * bfhi(zr[2].y));
            ob.z = pk2(bflo(ub.z) * bflo(zr[3].x), bfhi(ub.z) * bfhi(zr[3].x)); ob.w = pk2(bflo(ub.w) * bflo(zr[3].y), bfhi(ub.w) * bfhi(zr[3].y));
            bf16* op = BRA + (tok0 + w * 16 + t2) * 768 + g * 64 + part * 16;
            *(u32x4*)op = oa; *(u32x4*)(op + 8) = ob;
            if (g < 7) {
#pragma unroll
                for (int kk = 0; kk < 4; ++kk) wf[kk] = wn[kk]; }
            asm volatile("" ::: "memory");
        }
    }
}

__device__ __forceinline__ void p4_scan(const Frame& F) {
    const float* SLOC = (const float*)(F.ws + WS_SLOC); bf16* ACOMB = (bf16*)(F.ws + WS_ACOMB); const float* LT = (const float*)(F.ws + WS_LT);
    if (F.tid >= 128) return;
    for (int wg = F.bid; wg < 256; wg += F.G) {
        const int b = wg >> 4, g = wg & 15, dir = F.tid >> 6, p = F.tid & 63;
        const float lr = LT[((dir * 16 + g) * 64 + p) * 2], li = LT[((dir * 16 + g) * 64 + p) * 2 + 1];
        float xr = 0.f, xi = 0.f;
        const size_t rowbase = (size_t)g * NCHUNK + (size_t)b * CPS;
        for (int c0 = 0; c0 < CPS; c0 += 16) {
            float sr[16], si[16];
#pragma unroll
            for (int k = 0; k < 16; ++k) { const int c = dir ? (CPS - 1 - (c0 + k)) : (c0 + k); const float* sp = SLOC + (rowbase + c) * 256 + dir * 128 + p; sr[k] = sp[0]; si[k] = sp[64]; }
#pragma unroll
            for (int k = 0; k < 16; ++k) { const int c = dir ? (CPS - 1 - (c0 + k)) : (c0 + k); bf16* op = ACOMB + (rowbase + c) * 512 + 256 + dir * 128 + p;
                op[0] = (bf16)f2bf(xr); op[64] = (bf16)f2bf(xi);
                const float nr = lr * xr - li * xi + sr[k], ni = lr * xi + li * xr + si[k]; xr = nr; xi = ni; }
        }
    }
}

__device__ __forceinline__ void p9_norm_router(const Frame& F, const bf16* X1) {
    const float* g2 = F.in[21]; const float* wrt = F.in[22]; unsigned char* H2 = (unsigned char*)(F.ws + WS_H2); float* PROBS = (float*)(F.ws + WS_PROBS);
    LAS float* WR = (LAS float*)F.lds;
    __syncthreads();
    for (int i = F.tid; i < 1024 * 16 / 4; i += NTHR) { const int d = i >> 2; *(LAS f32x4*)(WR + d * 16 + (d >> 2) * 4 + (i & 3) * 4) = ((const f32x4*)wrt)[i]; }
    __syncthreads();
    const int gw = F.bid * NWAVES + F.wave, NGW = F.G * NWAVES, lane = F.lane;
    u32x2 wnx[2][4]; if (gw * 2 < NTOK) load_rows_bf16_raw<2>(X1 + (size_t)(NTOK - 2 - gw * 2) * 1024, lane, wnx);
    for (int mf = gw * 2; mf < NTOK; mf += NGW * 2) {
        const int m = NTOK - 2 - mf;
        f32x4 v[2][4]; rows_from_raw<2>(wnx, v);
        if (mf + NGW * 2 < NTOK) load_rows_bf16_raw<2>(X1 + (size_t)(m - NGW * 2) * 1024, lane, wnx);
        rms_scale_rows<2>(g2, lane, v);
        f32x2 lgp[2][8];
#pragma unroll
        for (int r = 0; r < 2; ++r) { store_row_fp8(H2 + (size_t)(m + r) * 1024, lane, v[r]);
#pragma unroll
            for (int e = 0; e < 8; ++e) lgp[r][e] = (f32x2){0.f, 0.f}; }
#pragma unroll
        for (int j = 0; j < 4; ++j)
#pragma unroll
            for (int q = 0; q < 4; ++q) { const int d = 4 * lane + 256 * j + q; const float h0 = v[0][j][q], h1 = v[1][j][q];
#pragma unroll
                for (int e4 = 0; e4 < 4; ++e4) { const f32x4 w4 = *(const LAS f32x4*)(WR + d * 16 + (d >> 2) * 4 + e4 * 4);
                    const f32x2 wa = (f32x2){w4.x, w4.y}, wb = (f32x2){w4.z, w4.w};
                    lgp[0][e4 * 2 + 0] += wa * h0; lgp[0][e4 * 2 + 1] += wb * h0;
                    lgp[1][e4 * 2 + 0] += wa * h1; lgp[1][e4 * 2 + 1] += wb * h1; }
                asm volatile("" ::: "memory"); }
        float lg[2][16];
#pragma unroll
        for (int r = 0; r < 2; ++r)
#pragma unroll
            for (int e = 0; e < 8; ++e) { lg[r][2 * e] = lgp[r][e].x; lg[r][2 * e + 1] = lgp[r][e].y; }
        float t8[2][8], t4[2][4], t2[2][2], t1[2];
        const bool b5 = lane & 32, b4 = lane & 16, b3 = lane & 8, b2 = lane & 4;
#pragma unroll
        for (int i = 0; i < 8; ++i)
#pragma unroll
            for (int r = 0; r < 2; ++r) { const float snd = b5 ? lg[r][i] : lg[r][i + 8], kp = b5 ? lg[r][i + 8] : lg[r][i]; t8[r][i] = kp + __shfl_xor(snd, 32); }
#pragma unroll
        for (int i = 0; i < 4; ++i)
#pragma unroll
            for (int r = 0; r < 2; ++r) { const float snd = b4 ? t8[r][i] : t8[r][i + 4], kp = b4 ? t8[r][i + 4] : t8[r][i]; t4[r][i] = kp + __shfl_xor(snd, 16); }
#pragma unroll
        for (int i = 0; i < 2; ++i)
#pragma unroll
            for (int r = 0; r < 2; ++r) { const float snd = b3 ? t4[r][i] : t4[r][i + 2], kp = b3 ? t4[r][i + 2] : t4[r][i]; t2[r][i] = kp + __shfl_xor(snd, 8); }
#pragma unroll
        for (int r = 0; r < 2; ++r) { const float snd = b2 ? t2[r][0] : t2[r][1], kp = b2 ? t2[r][1] : t2[r][0]; t1[r] = kp + __shfl_xor(snd, 4); }
#pragma unroll
        for (int r = 0; r < 2; ++r) t1[r] += __shfl_xor(t1[r], 1);
#pragma unroll
        for (int r = 0; r < 2; ++r) t1[r] += __shfl_xor(t1[r], 2);
        float mx[2] = {t1[0], t1[1]};
#pragma unroll
        for (int o = 4; o < 64; o <<= 1)
#pragma unroll
            for (int r = 0; r < 2; ++r) mx[r] = fmaxf(mx[r], __shfl_xor(mx[r], o));
        float ex[2], den[2];
#pragma unroll
        for (int r = 0; r < 2; ++r) { ex[r] = expf(t1[r] - mx[r]); den[r] = ex[r]; }
#pragma unroll
        for (int o = 4; o < 64; o <<= 1)
#pragma unroll
            for (int r = 0; r < 2; ++r) den[r] += __shfl_xor(den[r], o);
#pragma unroll
        for (int r = 0; r < 2; ++r) { const int mm = m + r;
            if ((lane & 3) == 0) PROBS[((size_t)(mm >> 12) * 16 + (lane >> 2)) * SEQ + (mm & (SEQ - 1))] = ex[r] / den[r]; }
    }
}

__device__ __forceinline__ int block_excl_scan(int v, LAS int* tmp, int tid, int lane, int wave, int& total) {
    int inc = v;
#pragma unroll
    for (int o = 1; o < 64; o <<= 1) { const int t = __shfl_up(inc, o); if (lane >= o) inc += t; }
    __syncthreads();
    if (lane == 63) tmp[wave] = inc;
    __syncthreads();
    int base = 0, tot = 0;
#pragma unroll
    for (int w = 0; w < 8; ++w) { const int t = tmp[w]; tot += t; if (w < wave) base += t; }
    total = tot; return base + inc - v;
}
__device__ __forceinline__ void p10_topk(const Frame& F) {
    const float* PROBS = (const float*)(F.ws + WS_PROBS); float* GATEV = (float*)(F.ws + WS_GATEV); int* SEL = (int*)(F.ws + WS_SEL);
    LAS int* red = (LAS int*)F.lds;
    int* TOKS = (int*)(F.ws + WS_TOKS);
    const int tid = F.tid, lane = F.lane, wave = F.wave;
    for (int pair = F.bid; pair < 256; pair += F.G) {
        const int e = pair >> 4, b = pair & 15;
        const float* src = PROBS + ((size_t)b * 16 + e) * SEQ + tid * 8;
        const f32x4 p0 = *(const f32x4*)src, p1 = *(const f32x4*)(src + 4);
        float vals[8] = {p0.x, p0.y, p0.z, p0.w, p1.x, p1.y, p1.z, p1.w};
        unsigned key[8];
#pragma unroll
        for (int i = 0; i < 8; ++i) key[i] = __builtin_bit_cast(unsigned, vals[i]);
        unsigned tau = 0u;
        __syncthreads();
        for (int bit = 29, rnd = 0; bit >= -1; bit -= 2, ++rnd) {
            const int sh = bit < 0 ? 0 : bit; const unsigned step = 1u << sh;
            const unsigned c1 = tau + step, c2 = bit < 0 ? c1 : tau + 2 * step, c3 = bit < 0 ? c1 : tau + 3 * step;
            int n1 = 0, n2 = 0, n3 = 0;
#pragma unroll
            for (int i = 0; i < 8; ++i) { n1 += __popcll(__ballot(key[i] >= c1)); n2 += __popcll(__ballot(key[i] >= c2)); n3 += __popcll(__ballot(key[i] >= c3)); }
            LAS int* r = red + (rnd & 1) * 32;
            if (lane == 0) { r[wave] = n1; r[8 + wave] = n2; r[16 + wave] = n3; }
            __syncthreads();
            int t1 = 0, t2 = 0, t3 = 0;
#pragma unroll
            for (int w = 0; w < 8; ++w) { t1 += r[w]; t2 += r[8 + w]; t3 += r[16 + w]; }
            if (t3 >= CAP) tau = c3; else if (t2 >= CAP) tau = c2; else if (t1 >= CAP) tau = c1;
        }
        int gtc = 0, eqc = 0;
#pragma unroll
        for (int i = 0; i < 8; ++i) { gtc += key[i] > tau ? 1 : 0; eqc += key[i] == tau ? 1 : 0; }
        int n_gt, n_eq;
        (void)block_excl_scan(gtc, red + 64, tid, lane, wave, n_gt);
        const int eq_before = block_excl_scan(eqc, red + 64, tid, lane, wave, n_eq);
        const int need_eq = CAP - n_gt;
        int selc = 0, er = eq_before; bool sel[8];
#pragma unroll
        for (int i = 0; i < 8; ++i) { bool s = key[i] > tau; if (key[i] == tau) { s = er < need_eq; ++er; } sel[i] = s; selc += s ? 1 : 0; }
        int n_sel; int slot = block_excl_scan(selc, red + 64, tid, lane, wave, n_sel);
#pragma unroll
        for (int i = 0; i < 8; ++i) { const int l = tid * 8 + i, tok = b * SEQ + l;
            if (sel[i]) { TOKS[(e * NB + b) * CAP + slot] = tok; GATEV[(e * NB + b) * CAP + slot] = vals[i]; SEL[(size_t)tok * 16 + e] = slot; ++slot; }
            else SEL[(size_t)tok * 16 + e] = -1; }
    }
}

__device__ __forceinline__ void p13_final(const Frame& F, const bf16* X1, float* OUT) {
    const float* fg = F.in[26]; const unsigned char* YS = (const unsigned char*)(F.ws + WS_YS); const int* SEL = (const int*)(F.ws + WS_SEL);
    const int gw = F.bid * NWAVES + F.wave, NGW = F.G * NWAVES, lane = F.lane;
    u32x2 wnx[2][4]; int slotn[2] = {-1, -1};
    if (gw * 2 < NTOK) { load_rows_bf16_raw<2>(X1 + (size_t)(gw * 2) * 1024, lane, wnx);
#pragma unroll
        for (int r = 0; r < 2; ++r) slotn[r] = (lane < 16) ? SEL[(size_t)(gw * 2 + r) * 16 + lane] : -1; }
    for (int m = gw * 2; m < NTOK; m += NGW * 2) {
        f32x4 v[2][4]; int myslot[2] = {slotn[0], slotn[1]};
        rows_from_raw<2>(wnx, v);
        if (m + NGW * 2 < NTOK) { load_rows_bf16_raw<2>(X1 + (size_t)(m + NGW * 2) * 1024, lane, wnx);
#pragma unroll
            for (int r = 0; r < 2; ++r) slotn[r] = (lane < 16) ? SEL[(size_t)(m + NGW * 2 + r) * 16 + lane] : -1; }
        const int b = m >> 12;
#pragma unroll
        for (int r = 0; r < 2; ++r) {
            unsigned long long mask = __ballot(myslot[r] >= 0);
            while (mask) {
                unsigned w4[4][4]; int ne = 0;
#pragma unroll
                for (int q = 0; q < 4; ++q) { if (mask) { const int e = __builtin_ctzll(mask); mask &= mask - 1; const int sl = __shfl(myslot[r], e);
                        const unsigned* yr = (const unsigned*)(YS + ((size_t)e * (NB * CAP) + b * CAP + sl) * 1024);
#pragma unroll
                        for (int j = 0; j < 4; ++j) w4[q][j] = yr[lane + 64 * j]; ne = q + 1; } }
#pragma unroll
                for (int q = 0; q < 4; ++q) { if (q < ne) {
#pragma unroll
                        for (int j = 0; j < 4; ++j) { const f32x2 lo = __builtin_amdgcn_cvt_pk_f32_fp8(w4[q][j], false), hi = __builtin_amdgcn_cvt_pk_f32_fp8(w4[q][j], true);
                            v[r][j].x += lo.x * 0.0625f; v[r][j].y += lo.y * 0.0625f; v[r][j].z += hi.x * 0.0625f; v[r][j].w += hi.y * 0.0625f; } } }
            }
        }
        rms_scale_rows<2>(fg, lane, v);
#pragma unroll
        for (int r = 0; r < 2; ++r)
#pragma unroll
            for (int j = 0; j < 4; ++j) ((f32x4*)(OUT + (size_t)(m + r) * 1024))[lane + 64 * j] = v[r][j];
    }
}

constexpr int NPHASE = 13;
__global__ void __launch_bounds__(NTHR, 2) fwd_kernel(Args args) {
    extern __shared__ __attribute__((aligned(16))) unsigned char lds_raw[];
    Frame F; F.lds = (LAS unsigned char*)lds_raw; F.tid = threadIdx.x; F.lane = F.tid & 63; F.wave = __builtin_amdgcn_readfirstlane(F.tid >> 6);
    F.G = gridDim.x; F.bid = blockIdx.x; F.ws = args.ws; F.in = args.in;
    const int lo = args.ph_lo, hi = args.ph_hi;
    volatile LAS unsigned* bst = (volatile LAS unsigned*)(F.lds + LDS_BYTES - 64);
    if (F.tid < 2) bst[F.tid] = 0u;
    __syncthreads();
    XcdBarrier bar; bar.bar = (unsigned*)args.ws; bar.x = 0; bar.st = bst;
    if (hi - lo > 1) bar = xcd_barrier_post((unsigned*)args.ws, bst);
    unsigned char* ws = args.ws; bf16* X1 = (bf16*)(ws + WS_X1B);
#define IN(k) (lo <= (k) && (k) < hi)
#define SEAM(k) do { if (IN(k) && IN((k) + 1)) { xcd_barrier(bar); } } while (0)
    using namespace pg8;
    if (IN(0)) { p0_s5_tables(F); p0_weights(F); p1_rmsnorm(F); }
    SEAM(0);
    if (IN(1)) {
        { DenseSched S; S.T.init(NTOK / 256, 5, 1, F.G, F.bid); S.T.rev = 1; S.A = (const char*)(ws + WS_H1); S.B = (const char*)(ws + WS_WIN_T); S.a_grp = 0; S.b_grp = 0; S.lda = 2048; S.K = 2048;
          EpiWin E{(bf16*)(ws + WS_UV), (bf16*)(ws + WS_ACOMB)}; gemm_phase(F.lds, S, E); } }
    SEAM(1);
    if (IN(2)) { s5_assemble_bmain(F); p3_gmlp(F); __syncthreads();
        DenseSched S; S.T.init(NCHUNK / 256, 1, 16, F.G, F.bid); S.A = (const char*)(ws + WS_ACOMB); S.B = (const char*)(ws + WS_BCO); S.a_grp = (size_t)NCHUNK * 512 * 2; S.b_grp = (size_t)256 * 256 * 2; S.lda = 1024; S.K = 512;
        EpiCarry E{(float*)(ws + WS_SLOC)}; gemm_phase(F.lds, S, E); }
    SEAM(2);
    if (IN(3)) { p4_scan(F); }
    SEAM(3);
    if (IN(4)) { DenseSched S; S.T.init(NCHUNK / 256, 1, 16, F.G, F.bid); S.A = (const char*)(ws + WS_ACOMB); S.B = (const char*)(ws + WS_BMAIN); S.a_grp = (size_t)NCHUNK * 512 * 2; S.b_grp = (size_t)256 * 512 * 2; S.lda = 1024; S.K = 1024;
        EpiS5 E{(bf16*)(ws + WS_Y)}; gemm_phase(F.lds, S, E); }
    SEAM(4);
    if (IN(5)) { DenseSched S; S.T.init(NTOK / 256, 1, 1, F.G, F.bid); S.A = (const char*)(ws + WS_Y); S.B = (const char*)(ws + WS_WGLU_T); S.a_grp = 0; S.b_grp = 0; S.lda = 512; S.K = 512;
        EpiGlu E{(const bf16*)(ws + WS_Y), (bf16*)(ws + WS_BRAB), args.in[17]}; gemm_phase(F.lds, S, E);
        { DenseSched S; S.T.init(NTOK / 256, 8, 1, F.G, F.bid); S.A = (const char*)(ws + WS_H1F8); S.B = (const char*)(ws + WS_WG8); S.a_grp = 0; S.b_grp = 0; S.lda = 1024; S.K = 1024;
          EpiGate E{(bf16*)(ws + WS_GATES), args.in[3]}; gemm_phase<EpiGate, DenseSched, true>(F.lds, S, E); } }
    SEAM(5);
    if (IN(6)) {
        DenseSched S; S.T.init(NTOK / 256, 4, 1, F.G, F.bid); S.T.rev = 1; S.A = (const char*)(ws + WS_BRAB); S.B = (const char*)(ws + WS_WUPAB_T); S.a_grp = 0; S.b_grp = 0; S.lda = 1536; S.K = 1536;
        EpiMerged E{(bf16*)(ws + WS_MERGED), (const bf16*)(ws + WS_GATES)}; gemm_phase(F.lds, S, E); }
    SEAM(6);
    if (IN(7)) { DenseSched S; S.T.init(NTOK / 256, 4, 1, F.G, F.bid); S.A = (const char*)(ws + WS_MERGED); S.B = (const char*)(ws + WS_WOUT_T); S.a_grp = 0; S.b_grp = 0; S.lda = 2048; S.K = 2048;
        EpiOut E{(const bf16*)(ws + WS_H1), (const float*)(ws + WS_RINV), args.in[1], X1}; gemm_phase(F.lds, S, E); }
    SEAM(7);
    if (IN(8)) { p9_norm_router(F, X1); }
    SEAM(8);
    if (IN(9)) { p10_topk(F); }
    SEAM(9);
    if (IN(10)) { GatherSched S; S.T.init((NB * CAP) / 256, (2 * FF) / 256, NE, F.G, F.bid); S.A = (const char*)(ws + WS_H2); S.B = (const char*)(ws + WS_WGU_T); S.toks = (const int*)(ws + WS_TOKS);
        S.rows_grp = NB * CAP; S.b_grp = (size_t)4096 * 1024; S.lda = 1024; S.K = 1024;
        EpiHid E{(unsigned char*)(ws + WS_HID)}; gemm_phase<EpiHid, GatherSched, true>(F.lds, S, E); }
    SEAM(10);
    if (IN(11)) { DenseSched S; S.T.init((NB * CAP) / 256, DM / 256, NE, F.G, F.bid); S.A = (const char*)(ws + WS_HID); S.B = (const char*)(ws + WS_WD_T); S.a_grp = (size_t)(NB * CAP) * FF; S.b_grp = (size_t)DM * FF; S.lda = FF; S.K = FF;
        EpiDown E{(unsigned char*)(ws + WS_YS), (const float*)(ws + WS_GATEV)}; gemm_phase<EpiDown, DenseSched, true>(F.lds, S, E); }
    SEAM(11);
    if (IN(12)) { p13_final(F, X1, args.out); }
#undef IN
#undef SEAM
}


extern "C" void kernel_launch(void* const* d_in, const int* in_sizes, int n_in, void* d_out, int out_size, void* d_ws, size_t ws_size, hipStream_t stream) {
    static int grid = 0;
    if (grid == 0) {
        if (n_in != 27 || out_size != NTOK * DM || ws_size < WS_END) { fprintf(stderr, "kernel_launch: unexpected shapes: n_in %d out %d ws %zu (need >= %zu)\n", n_in, out_size, ws_size, (size_t)WS_END); grid = -1; return; }
        int dev = 0, cus = 0, per_cu = 0;
        if (hipGetDevice(&dev) != hipSuccess || hipDeviceGetAttribute(&cus, hipDeviceAttributeMultiprocessorCount, dev) != hipSuccess) { grid = -1; return; }
        if (hipFuncSetAttribute((const void*)fwd_kernel, hipFuncAttributeMaxDynamicSharedMemorySize, LDS_BYTES) != hipSuccess) { fprintf(stderr, "kernel_launch: hipFuncSetAttribute failed\n"); grid = -1; return; }
        if (hipOccupancyMaxActiveBlocksPerMultiprocessor(&per_cu, (const void*)fwd_kernel, NTHR, LDS_BYTES) != hipSuccess || per_cu < 1) { fprintf(stderr, "kernel_launch: occupancy query says %d\n", per_cu); per_cu = 1; }
        (void)hipGetLastError();
        grid = cus;
    }
    if (grid < 0) return;
    Args a{};
    for (int i = 0; i < 27; ++i) a.in[i] = (const float*)d_in[i];
    a.out = (float*)d_out; a.ws = (unsigned char*)d_ws;
#if MK_ONE_LAUNCH
    a.ph_lo = 0; a.ph_hi = NPHASE;
    (void)hipMemsetAsync(d_ws, 0, 16384, stream);
    hipLaunchKernelGGL(fwd_kernel, dim3(grid), dim3(NTHR), LDS_BYTES, stream, a);
#else
    for (int p = 0; p < NPHASE; ++p) { a.ph_lo = p; a.ph_hi = p + 1; hipLaunchKernelGGL(fwd_kernel, dim3(grid), dim3(NTHR), LDS_BYTES, stream, a); }
#endif
}
```

```cpp
#include <hip/hip_runtime.h>
#include <cstdio>
#include <cstdint>

#ifndef MK_ONE_LAUNCH
#define MK_ONE_LAUNCH 1
#endif

#define GAS __attribute__((address_space(1)))
#define LAS __attribute__((address_space(3)))
typedef unsigned short bf16;
typedef short bf16x8 __attribute__((ext_vector_type(8)));
typedef float f32x4 __attribute__((ext_vector_type(4)));
typedef float f32x2 __attribute__((ext_vector_type(2)));
typedef unsigned u32x4 __attribute__((ext_vector_type(4)));
typedef unsigned u32x2 __attribute__((ext_vector_type(2)));

constexpr int NB = 16, SEQ = 4096, DM = 1024, NTOK = NB * SEQ;
constexpr int PT = 3328;
constexpr int NE = 16, CAP = 512, FF = 2048;
constexpr int TCH = 16, NCHUNK = NTOK / TCH, CPS = SEQ / TCH;
constexpr float EPS = 1e-6f;
constexpr int NWAVES = 8, NTHR = 512;

constexpr size_t MiB = 1u << 20;
constexpr size_t WS_WIN_T = 1 * MiB;
constexpr size_t WS_WS = 8 * MiB;
constexpr size_t WS_WGLU_T = 8 * MiB + 512 * 1024;
constexpr size_t WS_WUPAB_T = 9 * MiB;
constexpr size_t WS_WOUT_T = 11 * MiB;
constexpr size_t WS_LT = 13 * MiB;
constexpr size_t WS_KT = 22 * MiB;
constexpr size_t WS_BCO = 14 * MiB;
constexpr size_t WS_BMAIN = 16 * MiB;
constexpr size_t WS_WG8 = 20 * MiB;
constexpr size_t WS_H1F8 = 96 * MiB;
constexpr size_t WS_WGU_T = 32 * MiB;
constexpr size_t WS_WD_T = 160 * MiB;
constexpr size_t WS_H1 = 224 * MiB;
constexpr size_t WS_MERGED = 736 * MiB;
constexpr size_t WS_RINV = 24 * MiB;
constexpr size_t WS_UV = 352 * MiB;
constexpr size_t WS_GATES = 480 * MiB;
constexpr size_t WS_HID = 480 * MiB;
constexpr size_t WS_X1B = 352 * MiB;
constexpr size_t WS_ACOMB = 736 * MiB;
constexpr size_t WS_SLOC = 800 * MiB;
constexpr size_t WS_BRAB = 864 * MiB;
constexpr size_t WS_Y = 960 * MiB;
constexpr size_t WS_H2 = 736 * MiB;
constexpr size_t WS_YS = 736 * MiB;
constexpr size_t WS_PROBS = 992 * MiB;
constexpr size_t WS_IDX = 996 * MiB;
constexpr size_t WS_GATEV = 997 * MiB;
constexpr size_t WS_TOKS = 997 * MiB + 512 * 1024;
constexpr size_t WS_SEL = 998 * MiB;
constexpr size_t WS_END = 1024 * MiB;

constexpr int LDS_BYTES = 147456;

typedef __bf16 bf16x2_t __attribute__((ext_vector_type(2)));
__device__ __forceinline__ unsigned cvt_pk_bf16(float lo, float hi) { f32x2 v = {lo, hi}; return __builtin_bit_cast(unsigned, __builtin_convertvector(v, bf16x2_t)); }
__device__ __forceinline__ unsigned f2bf(float f) { return (unsigned)__builtin_bit_cast(unsigned short, (__bf16)f); }
__device__ __forceinline__ unsigned pk2(float lo, float hi) { return cvt_pk_bf16(lo, hi); }
__device__ __forceinline__ unsigned pk4_fp8(float a, float b, float c, float d) { unsigned w = 0u; w = __builtin_amdgcn_cvt_pk_fp8_f32(a, b, w, false); w = __builtin_amdgcn_cvt_pk_fp8_f32(c, d, w, true); return w; }
__device__ __forceinline__ float bflo(unsigned w) { return __builtin_bit_cast(float, w << 16); }
__device__ __forceinline__ float bfhi(unsigned w) { return __builtin_bit_cast(float, w & 0xffff0000u); }
__device__ __forceinline__ float wave_sum(float v) {
#pragma unroll
    for (int o = 1; o < 64; o <<= 1) v += __shfl_xor(v, o);
    return v;
}
__device__ __forceinline__ float sigmoid_f(float x) { return __builtin_amdgcn_rcpf(1.0f + __builtin_amdgcn_exp2f(-1.4426950408889634f * x)); }
__device__ __forceinline__ f32x2 gelu_pk(f32x2 v) {
    const f32x2 av = __builtin_elementwise_abs(v), d = av * 0.2316418882f + 1.0f;
    f32x2 t; t.x = __builtin_amdgcn_rcpf(d.x); t.y = __builtin_amdgcn_rcpf(d.y);
    f32x2 q = t * 0.5307027145f + (-0.7265760135f); q = q * t + 0.7107068705f; q = q * t + (-0.142248368f); q = q * t + 0.127414796f; q = q * t;
    const f32x2 s = (v * v) * (-0.72134752044f);
    f32x2 e; e.x = __builtin_amdgcn_exp2f(s.x); e.y = __builtin_amdgcn_exp2f(s.y);
    const f32x2 m = v * (q * e), r = v - m;
    f32x2 o; o.x = v.x < 0.f ? m.x : r.x; o.y = v.y < 0.f ? m.y : r.y; return o;
}
__device__ __forceinline__ f32x4 gelu4(f32x4 v) { f32x2 a = gelu_pk((f32x2){v[0], v[1]}), b = gelu_pk((f32x2){v[2], v[3]}); return (f32x4){a.x, a.y, b.x, b.y}; }
__device__ __forceinline__ u32x4 pack8(f32x4 v0, f32x4 v1) { u32x4 w; w.x = cvt_pk_bf16(v0[0], v0[1]); w.y = cvt_pk_bf16(v0[2], v0[3]); w.z = cvt_pk_bf16(v1[0], v1[1]); w.w = cvt_pk_bf16(v1[2], v1[3]); return w; }

namespace pg8 {
constexpr int BM = 256, BK = 64, HALF = 128, HTB = HALF * BK * 2, STAGE_BYTES = 8 * HTB, NXCD = 8, WGM = 8;
__host__ __device__ __forceinline__ int lds_byte(int r, int c) { const int st = (r >> 4) * 2 + (c >> 5), rr = r & 15, cc = c & 31, ob = rr * 64 + cc * 2; return st * 1024 + (ob ^ (((ob >> 9) & 1) << 5)); }
__host__ __device__ __forceinline__ void stage_rc(int b, int& R, int& C) { const int st = b / 1024, sb = b % 1024, swz = sb ^ (((sb >> 9) & 1) << 5); R = (st >> 1) * 16 + swz / 64; C = (st & 1) * 32 + (swz % 64) / 2; }
__host__ __device__ __forceinline__ int perm32(int rho) { const int n = rho >> 4, i = rho & 15; return 8 * (i >> 2) + 4 * n + (i & 3); }

struct Unit { unsigned A, B; int pm, pn, grp; };

struct TileOrder {
    int nM, nN, upg, total, G, c, rev;
    __device__ __forceinline__ void init(int nM_, int nN_, int ngrp, int G_, int c_) { nM = nM_; nN = nN_; upg = nM * nN; total = upg * ngrp; G = G_; c = c_; rev = 0; }
    __device__ __forceinline__ bool tile(int i, int& grp, int& pm, int& pn) const {
        const int L = i * G + c; if (L >= total) return false;
        grp = L / upg; int wgid = L - grp * upg;
        { const int nwg = upg, q = nwg / NXCD, r = nwg % NXCD, xcd = wgid % NXCD, off = wgid / NXCD; wgid = (xcd < r ? xcd * (q + 1) : r * (q + 1) + (xcd - r) * q) + off; }
        const int nig = WGM * nN, gid = wgid / nig, fm = gid * WGM, gsz = (nM - fm) < WGM ? (nM - fm) : WGM;
        pm = fm + ((wgid % nig) % gsz); pn = (wgid % nig) / gsz; if (rev) pm = nM - 1 - pm; return true;
    }
};
struct DenseSched {
    static constexpr bool GATHER = false;
    __device__ __forceinline__ const int* rows(const Unit&) const { return nullptr; }
    __device__ __forceinline__ const int* table() const { return nullptr; }
    TileOrder T; const char* A; const char* B; size_t a_grp, b_grp; int lda, K;
    __device__ __forceinline__ bool next(int i, Unit& u) const {
        int g, pm, pn; if (!T.tile(i, g, pm, pn)) return false;
        u.pm = pm; u.pn = pn; u.grp = g; u.A = (unsigned)((size_t)g * a_grp + (size_t)pm * BM * lda); u.B = (unsigned)((size_t)g * b_grp + (size_t)pn * BM * K); return true;
    }
};
struct GatherSched {
    static constexpr bool GATHER = true;
    TileOrder T; const char* A; const char* B; const int* toks; size_t b_grp; int rows_grp, lda, K;
    __device__ __forceinline__ bool next(int i, Unit& u) const {
        int g, pm, pn; if (!T.tile(i, g, pm, pn)) return false;
        u.pm = pm; u.pn = pn; u.grp = g; u.A = 0u; u.B = (unsigned)((size_t)g * b_grp + (size_t)pn * BM * K); return true;
    }
    __device__ __forceinline__ const int* rows(const Unit& u) const { return toks + u.grp * rows_grp + u.pm * BM; }
    __device__ __forceinline__ const int* table() const { return toks; }
};
__host__ __device__ __forceinline__ int f8_swz(int fr) { const int h = fr >> 1, sw = ((h & 1) << 1) | ((h >> 1) & 1); return (h & 4) | (sw ^ (h >> 2)); }
typedef int v8i32 __attribute__((ext_vector_type(8)));
typedef int v4i32 __attribute__((ext_vector_type(4)));
template <class E, class = void> struct EpiHook { static constexpr int T = 0; template <class A, class U> static __device__ __forceinline__ void run(const E&, A&, const U&, int, int, int, int) {} };
template <class E> struct EpiHook<E, decltype((void)E::HOOK_T)> { static constexpr int T = E::HOOK_T; template <class A, class U> static __device__ __forceinline__ void run(const E& e, A& acc, const U& u, int wr, int wc, int fr, int fq) { e.mid(acc, u, wr, wc, fr, fq); } };
template <class Epi, class Sched, bool F8 = false>
__device__ __forceinline__ void gemm_phase(LAS unsigned char* lds, const Sched& S, const Epi& E) {
    const int tid = threadIdx.x, wid = __builtin_amdgcn_readfirstlane(tid >> 6), lane = tid & 63, wr = wid >> 2, wc = wid & 3, fr = lane & 15, fq = lane >> 4;
    const int K = S.K, nt = K / 128;
    int R0, C0;
    if (F8) { R0 = tid >> 3; C0 = ((tid & 7) ^ f8_swz(R0 & 15)) * 16; }
    else { int c; stage_rc(tid * 16, R0, c); C0 = c * 2; }
    const int Rb = Epi::PERM ? ((R0 & ~31) + perm32(R0 & 31)) : R0;
    const unsigned vB = (unsigned)(Rb * K + C0), vA = (unsigned)(R0 * S.lda + C0);
    const unsigned kstep = 128u, hstepB = (unsigned)(HALF * K), qstepB = (unsigned)(64 * K), hstepA = (unsigned)(HALF * S.lda), qstepA = (unsigned)(64 * S.lda);
    const __amdgpu_buffer_rsrc_t srdA = __builtin_amdgcn_make_buffer_rsrc((void*)S.A, 0, -16, 0x00020000), srdB = __builtin_amdgcn_make_buffer_rsrc((void*)S.B, 0, -16, 0x00020000);
    const unsigned ldsw = (unsigned)wid * 1024u;
    const int aoff = F8 ? (wr * 64 + fr) * 128 + (((2 * fq) ^ f8_swz(fr)) << 4) : lds_byte(wr * 64 + fr, fq * 8), boff = F8 ? (wc * 32 + fr) * 128 + (((2 * fq) ^ f8_swz(fr)) << 4) : lds_byte(wc * 32 + fr, fq * 8);
    const int aoff1 = F8 ? (aoff ^ 16) : aoff + 1024, boff1 = F8 ? (boff ^ 16) : boff + 1024;
#define PG8_SA(b, h) (((b) * 2 + (h)) * HTB)
#define PG8_SB(b, h) ((4 + (b) * 2 + (h)) * HTB)
#define PG8_STAGE2(srd, bufoff, voff, soff, qstep) do { \
        __builtin_amdgcn_raw_ptr_buffer_load_lds(srd, (LAS void*)(lds + (bufoff) + ldsw), 16, (int)(voff), (int)(soff), 0, 0); \
        __builtin_amdgcn_raw_ptr_buffer_load_lds(srd, (LAS void*)(lds + (bufoff) + ldsw + 8192), 16, (int)(voff), (int)((soff) + (qstep)), 0, 0); } while (0)
#define PG8_STAGEAG(b, h, soff, par) do { if (Sched::GATHER) { \
        const LAS int* tp_ = (const LAS int*)(lds + 131072 + (par) * 1024 + tabA + (h) * 512); const unsigned o0_ = ((unsigned)tp_[0] << 10) + gC0, o1_ = ((unsigned)tp_[64] << 10) + gC0; \
        __builtin_amdgcn_raw_ptr_buffer_load_lds(srdA, (LAS void*)(lds + PG8_SA(b, h) + ldsw), 16, (int)o0_, (int)(soff), 0, 0); \
        __builtin_amdgcn_raw_ptr_buffer_load_lds(srdA, (LAS void*)(lds + PG8_SA(b, h) + ldsw + 8192), 16, (int)o1_, (int)(soff), 0, 0); } \
        else PG8_STAGE2(srdA, PG8_SA(b, h), vA, (soff) + (h) * hstepA, qstepA); } while (0)
#define PG8_STAGEA(b, h, soff) PG8_STAGEAG(b, h, soff, ui & 1)
#define PG8_STAGEB(b, h, soff) PG8_STAGE2(srdB, PG8_SB(b, h), vB, (soff) + (h) * hstepB, qstepB)
#define PG8_LDA(dst, b, h) do { _Pragma("unroll") for (int m = 0; m < 4; ++m) { \
        if (F8) { const v4i32 lo_ = *(const LAS v4i32*)(lds + PG8_SA(b, h) + aoff + m * 2048), hi_ = *(const LAS v4i32*)(lds + PG8_SA(b, h) + aoff1 + m * 2048); dst##8[m] = __builtin_shufflevector(lo_, hi_, 0, 1, 2, 3, 4, 5, 6, 7); } \
        else { dst[m][0] = *(const LAS bf16x8*)(lds + PG8_SA(b, h) + aoff + m * 2048); dst[m][1] = *(const LAS bf16x8*)(lds + PG8_SA(b, h) + aoff1 + m * 2048); } } } while (0)
#define PG8_LDB(dst, b, h) do { _Pragma("unroll") for (int n = 0; n < 2; ++n) { \
        if (F8) { const v4i32 lo_ = *(const LAS v4i32*)(lds + PG8_SB(b, h) + boff + n * 2048), hi_ = *(const LAS v4i32*)(lds + PG8_SB(b, h) + boff1 + n * 2048); dst##8[n] = __builtin_shufflevector(lo_, hi_, 0, 1, 2, 3, 4, 5, 6, 7); } \
        else { dst[n][0] = *(const LAS bf16x8*)(lds + PG8_SB(b, h) + boff + n * 2048); dst[n][1] = *(const LAS bf16x8*)(lds + PG8_SB(b, h) + boff1 + n * 2048); } } } while (0)
#define PG8_MMA(ai, bj, At, Bt) do { __builtin_amdgcn_s_setprio(1); _Pragma("unroll") for (int m = 0; m < 4; ++m) _Pragma("unroll") for (int n = 0; n < 2; ++n) { \
        if (F8) acc[ai][bj][m][n] = __builtin_amdgcn_mfma_scale_f32_16x16x128_f8f6f4(Bt##8[n], At##8[m], acc[ai][bj][m][n], 0, 0, 0, 0, 0, 0);     \
        else { _Pragma("unroll") for (int k = 0; k < 2; ++k) acc[ai][bj][m][n] = __builtin_amdgcn_mfma_f32_16x16x32_bf16(Bt[n][k], At[m][k], acc[ai][bj][m][n], 0, 0, 0); } } \
        __builtin_amdgcn_s_setprio(0); } while (0)
#define PG8_WAIT_V(n) asm volatile("s_waitcnt vmcnt(" #n ")" ::: "memory")
#define PG8_WAIT_L(n) asm volatile("s_waitcnt lgkmcnt(" #n ")" ::: "memory")
#define PG8_BAR __builtin_amdgcn_s_barrier()
#define PG8_SCHED __builtin_amdgcn_sched_barrier(0)
    Unit cur, nxt; int ui = 0;
    if (!S.next(0, cur)) return;
    f32x4 acc[2][2][4][2];
#pragma unroll
    for (int a = 0; a < 2; ++a)
#pragma unroll
        for (int b = 0; b < 2; ++b)
#pragma unroll
            for (int m = 0; m < 4; ++m)
#pragma unroll
                for (int n = 0; n < 2; ++n) acc[a][b][m][n] = (f32x4){0.f, 0.f, 0.f, 0.f};
    bf16x8 At[4][2], B0[2][2], B1[2][2]; v8i32 At8[4], B08[2], B18[2];
    unsigned cA = cur.A, cB = cur.B;
    const unsigned gC0 = (unsigned)C0, tabA = (unsigned)R0 * 4u;
    const __amdgpu_buffer_rsrc_t srdT = __builtin_amdgcn_make_buffer_rsrc((void*)S.table(), 0, -16, 0x00020000);
    const int* rows0 = S.table();
#define PG8_TAB(par, u_) do { if (wid < 4) __builtin_amdgcn_raw_ptr_buffer_load_lds(srdT, (LAS void*)(lds + 131072 + (par) * 1024 + wid * 256), 4, (int)(lane * 4), (int)((S.rows(u_) - rows0) * 4 + wid * 256), 0, 0); } while (0)
    if (Sched::GATHER) { PG8_TAB(0, cur); PG8_WAIT_V(0); PG8_BAR; }
    PG8_STAGEB(0, 0, cB); PG8_STAGEB(0, 1, cB); PG8_STAGEA(0, 0, cA); PG8_STAGEA(0, 1, cA);
    if (wr == 1) PG8_BAR;
    PG8_WAIT_V(2); PG8_BAR;
    PG8_STAGEB(1, 0, cB + kstep); PG8_STAGEB(1, 1, cB + kstep);
    PG8_WAIT_V(4); PG8_BAR;
    for (;;) {
        const bool has_next = S.next(ui + 1, nxt);
        const unsigned nA = has_next ? nxt.A : cA, nB = has_next ? nxt.B : cB;
#pragma clang loop unroll(disable)
        for (int t = 0; t < nt; t += 2) {
            const bool last = (t == nt - 2);
            if (Sched::GATHER && has_next && t == 0) PG8_TAB((ui + 1) & 1, nxt);
            const unsigned a1 = cA + (unsigned)(t + 1) * kstep;
            const unsigned a2 = last ? nA : cA + (unsigned)(t + 2) * kstep, b2 = last ? nB : cB + (unsigned)(t + 2) * kstep;
            const unsigned a3 = a2 + kstep, b3 = b2 + kstep;
            PG8_LDB(B0, 0, 0); PG8_LDB(B1, 0, 1); PG8_SCHED; PG8_LDA(At, 0, 0); PG8_STAGEA(1, 0, a1); PG8_STAGEA(1, 1, a1);
            PG8_WAIT_V(8); PG8_WAIT_L(0); PG8_BAR; PG8_MMA(0, 0, At, B0); PG8_MMA(0, 1, At, B1); PG8_BAR; PG8_SCHED;
            PG8_LDA(At, 0, 1); PG8_STAGEB(0, 0, b2); PG8_STAGEB(0, 1, b2);
            PG8_WAIT_V(6); PG8_WAIT_L(0); PG8_BAR; PG8_MMA(1, 0, At, B0); PG8_MMA(1, 1, At, B1); PG8_BAR; PG8_SCHED;
            PG8_LDB(B0, 1, 0); PG8_LDB(B1, 1, 1); PG8_SCHED; PG8_LDA(At, 1, 0); PG8_STAGEAG(0, 0, a2, (ui + ((last && has_next) ? 1 : 0)) & 1); PG8_STAGEAG(0, 1, a2, (ui + ((last && has_next) ? 1 : 0)) & 1);
            PG8_WAIT_V(8); PG8_WAIT_L(0); PG8_BAR; PG8_MMA(0, 0, At, B0); PG8_MMA(0, 1, At, B1); PG8_BAR; PG8_SCHED;
            PG8_LDA(At, 1, 1); PG8_STAGEB(1, 0, b3); PG8_STAGEB(1, 1, b3);
            PG8_WAIT_V(6); PG8_WAIT_L(0); PG8_BAR; PG8_MMA(1, 0, At, B0); PG8_MMA(1, 1, At, B1); PG8_BAR; PG8_SCHED;
            if (EpiHook<Epi>::T > 0 && t + 2 == EpiHook<Epi>::T) EpiHook<Epi>::run(E, acc, cur, wr, wc, fr, fq);
        }
        if (wr == 0) PG8_BAR;
        E(acc, cur, wr, wc, fr, fq);
        if (!has_next) break;
#pragma unroll
        for (int a = 0; a < 2; ++a)
#pragma unroll
            for (int b = 0; b < 2; ++b)
#pragma unroll
                for (int m = 0; m < 4; ++m)
#pragma unroll
                    for (int n = 0; n < 2; ++n) { double z0, z1; asm volatile("v_mov_b64 %0, 0" : "=v"(z0)); asm volatile("v_mov_b64 %0, 0" : "=v"(z1));
                        const f32x2 lo = __builtin_bit_cast(f32x2, z0), hi = __builtin_bit_cast(f32x2, z1); acc[a][b][m][n] = (f32x4){lo.x, lo.y, hi.x, hi.y}; }
        cur = nxt; cA = nA; cB = nB; ++ui;
        if (wr == 1) PG8_BAR;
    }
    PG8_WAIT_V(0);
    PG8_BAR;
#undef PG8_TAB
#undef PG8_SA
#undef PG8_SB
#undef PG8_STAGE2
#undef PG8_STAGEA
#undef PG8_STAGEAG
#undef PG8_STAGEB
#undef PG8_LDA
#undef PG8_LDB
#undef PG8_MMA
#undef PG8_WAIT_V
#undef PG8_WAIT_L
#undef PG8_BAR
#undef PG8_SCHED
}

#define EPI_LOOP_ROWS for (int ai = 0; ai < 2; ++ai) _Pragma("unroll") for (int m = 0; m < 4; ++m)
struct EpiWin {
    static constexpr bool PERM = true;
    bf16* UV; bf16* ACOMB;
    __device__ __forceinline__ void operator()(const f32x4 (&acc)[2][2][4][2], const Unit& u, int wr, int wc, int fr, int fq) const {
        const int row0 = u.pm * BM + wr * 64 + fr, cw = wc * 32 + 8 * fq;
        if (u.pn < 4) {
#pragma unroll
            EPI_LOOP_ROWS { bf16* rowp = UV + (size_t)(row0 + ai * HALF + m * 16) * 1024 + u.pn * BM + cw;
#pragma unroll
                for (int bj = 0; bj < 2; ++bj) *(u32x4*)(rowp + bj * HALF) = pack8(gelu4(acc[ai][bj][m][0]), gelu4(acc[ai][bj][m][1])); }
        } else {
#pragma unroll
            EPI_LOOP_ROWS { const int row = row0 + ai * HALF + m * 16, chunk = row >> 4, j = row & 15;
#pragma unroll
                for (int bj = 0; bj < 2; ++bj) { const int c = bj * HALF + cw, g = c >> 4, h0 = c & 15;
                    *(u32x4*)(ACOMB + ((size_t)g * NCHUNK + chunk) * 512 + j * 16 + h0) = pack8(acc[ai][bj][m][0], acc[ai][bj][m][1]); } }
        }
    }
};
struct EpiGate {
    static constexpr bool PERM = true;
    bf16* GATES; const float* b_gate;
    __device__ __forceinline__ void operator()(const f32x4 (&acc)[2][2][4][2], const Unit& u, int wr, int wc, int fr, int fq) const {
        const int gc0 = u.pn * HALF + wc * 32 + 8 * fq;
        constexpr float NL2E = -1.4426950408889634f, CS = NL2E * 0.0625f;
        f32x2 pa[4], pb[4];
#pragma unroll
        for (int j = 0; j < 4; ++j) { pa[j] = (f32x2){b_gate[gc0 + 2 * j], b_gate[gc0 + 2 * j + 1]} * NL2E; pb[j] = (f32x2){b_gate[1024 + gc0 + 2 * j], b_gate[1024 + gc0 + 2 * j + 1]} * NL2E; }
        const size_t gidx = ((size_t)u.pm * 8 + u.pn) * 4096 + ((wr * 4 + wc) * 64 + fq * 16 + fr);
        u32x4* rbase = (u32x4*)GATES + gidx; u32x2* qbase = (u32x2*)((char*)GATES + 128 * MiB) + gidx;
#pragma unroll
        EPI_LOOP_ROWS {
            u32x2 qw; qw.x = 0u; qw.y = 0u; u32x4 rw;
#pragma unroll
            for (int j = 0; j < 4; ++j) {
                const f32x4 ap = acc[ai][0][m][j >> 1], ag = acc[ai][1][m][j >> 1];
                const f32x2 p2 = (j & 1) ? (f32x2){ap[2], ap[3]} : (f32x2){ap[0], ap[1]}, g2 = (j & 1) ? (f32x2){ag[2], ag[3]} : (f32x2){ag[0], ag[1]};
                const f32x2 tp = p2 * CS + pa[j], tg = g2 * CS + pb[j];
                f32x2 dp, dg; dp.x = __builtin_amdgcn_exp2f(tp.x); dp.y = __builtin_amdgcn_exp2f(tp.y); dg.x = __builtin_amdgcn_exp2f(tg.x); dg.y = __builtin_amdgcn_exp2f(tg.y);
                dp = dp + 1.0f; dg = dg + 1.0f;
                f32x2 qf; qf.x = __builtin_amdgcn_rcpf(dg.x); qf.y = __builtin_amdgcn_rcpf(dg.y); qf = qf * 255.0f + 0.5f;
                qf.x = fmaxf(qf.x, 1.0f); qf.y = fmaxf(qf.y, 1.0f);
                unsigned qd = (j < 2) ? qw.x : qw.y;
                qd = __builtin_amdgcn_cvt_pk_u8_f32(qf.x, (2 * j) & 3, qd); qd = __builtin_amdgcn_cvt_pk_u8_f32(qf.y, (2 * j + 1) & 3, qd);
                if (j < 2) qw.x = qd; else qw.y = qd;
                f32x2 qs; qs.x = (float)((qd >> (8 * ((2 * j) & 3))) & 0xffu); qs.y = (float)((qd >> (8 * ((2 * j + 1) & 3))) & 0xffu);
                const f32x2 den = qs * dp; f32x2 r2; r2.x = __builtin_amdgcn_rcpf(den.x); r2.y = __builtin_amdgcn_rcpf(den.y); r2 = r2 * 255.0f;
                const unsigned rp = cvt_pk_bf16(r2.x, r2.y);
                if (j == 0) rw.x = rp; else if (j == 1) rw.y = rp; else if (j == 2) rw.z = rp; else rw.w = rp; }
            rbase[ai * 2048 + m * 512] = rw; qbase[ai * 2048 + m * 512] = qw; }
    }
};
struct EpiCarry {
    static constexpr bool PERM = false;
    float* SLOC;
    __device__ __forceinline__ void operator()(const f32x4 (&acc)[2][2][4][2], const Unit& u, int wr, int wc, int fr, int fq) const {
        const int row0 = u.pm * BM + wr * 64 + fr, col0 = wc * 32 + 4 * fq;
#pragma unroll
        EPI_LOOP_ROWS { float* rowp = SLOC + ((size_t)u.grp * NCHUNK + row0 + ai * HALF + m * 16) * 256 + col0;
#pragma unroll
            for (int bj = 0; bj < 2; ++bj)
#pragma unroll
                for (int n = 0; n < 2; ++n) *(f32x4*)(rowp + bj * HALF + n * 16) = acc[ai][bj][m][n]; }
    }
};
struct EpiS5 {
    static constexpr bool PERM = true;
    bf16* Y;
    __device__ __forceinline__ void operator()(const f32x4 (&acc)[2][2][4][2], const Unit& u, int wr, int wc, int fr, int fq) const {
        const int row0 = u.pm * BM + wr * 64 + fr, cw = wc * 32 + 8 * fq;
#pragma unroll
        EPI_LOOP_ROWS { const int chunk = row0 + ai * HALF + m * 16;
#pragma unroll
            for (int bj = 0; bj < 2; ++bj) { const int c = bj * HALF + cw, i = c >> 4, h0 = c & 15;
                *(u32x4*)(Y + ((size_t)chunk * TCH + i) * 256 + u.grp * 16 + h0) = pack8(gelu4(acc[ai][bj][m][0]), gelu4(acc[ai][bj][m][1])); } }
    }
};
struct EpiGlu {
    static constexpr bool PERM = true;
    const bf16* Y; bf16* BRB; const float* b_glu;
    __device__ __forceinline__ void operator()(const f32x4 (&acc)[2][2][4][2], const Unit& u, int wr, int wc, int fr, int fq) const {
        const int row0 = u.pm * BM + wr * 64 + fr, cw = wc * 32 + 8 * fq;
        f32x4 bv[2][2];
#pragma unroll
        for (int bj = 0; bj < 2; ++bj)
#pragma unroll
            for (int n = 0; n < 2; ++n) bv[bj][n] = *(const f32x4*)(b_glu + cw + bj * HALF + 4 * n);
#pragma unroll
        for (int ai = 0; ai < 2; ++ai) {
            u32x4 yv[4][2];
#pragma unroll
            for (int m = 0; m < 4; ++m)
#pragma unroll
                for (int bj = 0; bj < 2; ++bj) yv[m][bj] = *(const u32x4*)(Y + (size_t)(row0 + ai * HALF + m * 16) * 256 + cw + bj * HALF);
#pragma unroll
            for (int m = 0; m < 4; ++m)
#pragma unroll
                for (int bj = 0; bj < 2; ++bj) { const u32x4 y = yv[m][bj];
                    f32x4 v0 = acc[ai][bj][m][0] + bv[bj][0], v1 = acc[ai][bj][m][1] + bv[bj][1];
                    v0[0] = bflo(y.x) * sigmoid_f(v0[0]); v0[1] = bfhi(y.x) * sigmoid_f(v0[1]); v0[2] = bflo(y.y) * sigmoid_f(v0[2]); v0[3] = bfhi(y.y) * sigmoid_f(v0[3]);
                    v1[0] = bflo(y.z) * sigmoid_f(v1[0]); v1[1] = bfhi(y.z) * sigmoid_f(v1[1]); v1[2] = bflo(y.w) * sigmoid_f(v1[2]); v1[3] = bfhi(y.w) * sigmoid_f(v1[3]);
                    *(u32x4*)(BRB + (size_t)(row0 + ai * HALF + m * 16) * 768 + 512 + cw + bj * HALF) = pack8(v0, v1); }
            asm volatile("" ::: "memory");
        }
    }
};
struct EpiMerged {
    static constexpr bool PERM = true; static constexpr int HOOK_T = 8;
    bf16* MERGED; const bf16* GATES;
    static __device__ __forceinline__ void mul8(f32x4& v0, f32x4& v1, const u32x4 g, const bool clamp, const bool inv) {
        float f[8] = {bflo(g.x), bfhi(g.x), bflo(g.y), bfhi(g.y), bflo(g.z), bfhi(g.z), bflo(g.w), bfhi(g.w)};
#pragma unroll
        for (int j = 0; j < 8; ++j) { if (clamp) f[j] = fmaxf(f[j], 1e-6f); if (inv) f[j] = __builtin_amdgcn_rcpf(f[j]); }
        v0 = v0 * (f32x4){f[0], f[1], f[2], f[3]}; v1 = v1 * (f32x4){f[4], f[5], f[6], f[7]};
    }
    __device__ __forceinline__ void mid(f32x4 (&acc)[2][2][4][2], const Unit& u, int wr, int wc, int fr, int fq) const {
        const u32x4* gbase = (const u32x4*)GATES + ((size_t)u.pm * 8 + 2 * u.pn) * 4096 + ((wr * 4 + wc) * 64 + fq * 16 + fr);
#pragma unroll
        for (int ai = 0; ai < 2; ++ai) {
            u32x4 gr[4][2];
#pragma unroll
            for (int m = 0; m < 4; ++m)
#pragma unroll
                for (int bj = 0; bj < 2; ++bj) gr[m][bj] = gbase[bj * 4096 + ai * 2048 + m * 512];
#pragma unroll
            for (int m = 0; m < 4; ++m)
#pragma unroll
                for (int bj = 0; bj < 2; ++bj) mul8(acc[ai][bj][m][0], acc[ai][bj][m][1], gr[m][bj], false, false);
            asm volatile("" ::: "memory");
        }
    }
    __device__ __forceinline__ void operator()(const f32x4 (&acc)[2][2][4][2], const Unit& u, int wr, int wc, int fr, int fq) const {
        const int row0 = u.pm * BM + wr * 64 + fr, col0 = u.pn * BM + wc * 32 + 8 * fq;
        const u32x2* qbase = (const u32x2*)((const char*)GATES + 128 * MiB) + ((size_t)u.pm * 8 + 2 * u.pn) * 4096 + ((wr * 4 + wc) * 64 + fq * 16 + fr);
#pragma unroll
        for (int ai = 0; ai < 2; ++ai) {
            u32x2 gb[4][2];
#pragma unroll
            for (int m = 0; m < 4; ++m)
#pragma unroll
                for (int bj = 0; bj < 2; ++bj) gb[m][bj] = qbase[bj * 4096 + ai * 2048 + m * 512];
#pragma unroll
            for (int m = 0; m < 4; ++m)
#pragma unroll
                for (int bj = 0; bj < 2; ++bj) { const u32x2 q = gb[m][bj];
                    const f32x4 s0 = (f32x4){(float)((q.x >> 0) & 0xffu), (float)((q.x >> 8) & 0xffu), (float)((q.x >> 16) & 0xffu), (float)((q.x >> 24) & 0xffu)} * (1.f / 255.f);
                    const f32x4 s1 = (f32x4){(float)((q.y >> 0) & 0xffu), (float)((q.y >> 8) & 0xffu), (float)((q.y >> 16) & 0xffu), (float)((q.y >> 24) & 0xffu)} * (1.f / 255.f);
                    *(u32x4*)(MERGED + (size_t)(row0 + ai * HALF + m * 16) * 1024 + col0 + bj * HALF) = pack8(acc[ai][bj][m][0] * s0, acc[ai][bj][m][1] * s1); }
            asm volatile("" ::: "memory");
        }
    }
};
struct EpiOut {
    static constexpr bool PERM = true;
    const bf16* H1; const float* RINV; const float* G1; bf16* X1B;
    __device__ __forceinline__ void operator()(const f32x4 (&acc)[2][2][4][2], const Unit& u, int wr, int wc, int fr, int fq) const {
        const int row0 = u.pm * BM + wr * 64 + fr, col0 = u.pn * BM + wc * 32 + 8 * fq;
        f32x4 gi[2][2];
#pragma unroll
        for (int bj = 0; bj < 2; ++bj)
#pragma unroll
            for (int n = 0; n < 2; ++n) { const f32x4 gv = *(const f32x4*)(G1 + col0 + bj * HALF + 4 * n); gi[bj][n] = (f32x4){1.f / gv.x, 1.f / gv.y, 1.f / gv.z, 1.f / gv.w}; }
#pragma unroll
        for (int ai = 0; ai < 2; ++ai) {
            u32x4 hv[4][2]; float ri[4];
#pragma unroll
            for (int m = 0; m < 4; ++m) { ri[m] = RINV[row0 + ai * HALF + m * 16];
#pragma unroll
                for (int bj = 0; bj < 2; ++bj) hv[m][bj] = *(const u32x4*)(H1 + (size_t)(row0 + ai * HALF + m * 16) * 1024 + col0 + bj * HALF); }
#pragma unroll
            for (int m = 0; m < 4; ++m)
#pragma unroll
                for (int bj = 0; bj < 2; ++bj) { const u32x4 h = hv[m][bj];
                    const f32x4 x0 = (f32x4){bflo(h.x), bfhi(h.x), bflo(h.y), bfhi(h.y)} * gi[bj][0] * ri[m], x1 = (f32x4){bflo(h.z), bfhi(h.z), bflo(h.w), bfhi(h.w)} * gi[bj][1] * ri[m];
                    *(u32x4*)(X1B + (size_t)(row0 + ai * HALF + m * 16) * 1024 + col0 + bj * HALF) = pack8(x0 + acc[ai][bj][m][0], x1 + acc[ai][bj][m][1]); }
            asm volatile("" ::: "memory");
        }
    }
};
struct EpiHid {
    static constexpr bool PERM = true;
    unsigned char* HID;
    __device__ __forceinline__ void operator()(const f32x4 (&acc)[2][2][4][2], const Unit& u, int wr, int wc, int fr, int fq) const {
        const int row0 = u.pm * BM + wr * 64 + fr, col0 = u.pn * HALF + wc * 32 + 8 * fq;
#pragma unroll
        EPI_LOOP_ROWS { const size_t row = (size_t)u.grp * (NB * CAP) + row0 + ai * HALF + m * 16;
            f32x2 pr[4];
#pragma unroll
            for (int q = 0; q < 4; ++q) { const f32x4 a4 = acc[ai][0][m][q >> 1], u4 = acc[ai][1][m][q >> 1];
                const f32x2 a2 = (q & 1) ? (f32x2){a4[2], a4[3]} : (f32x2){a4[0], a4[1]}, u2 = (q & 1) ? (f32x2){u4[2], u4[3]} : (f32x2){u4[0], u4[1]};
                const f32x2 t2 = a2 * (-0.09016844005556021f); f32x2 e2; e2.x = __builtin_amdgcn_exp2f(t2.x); e2.y = __builtin_amdgcn_exp2f(t2.y);
                const f32x2 d2 = e2 * 256.0f + 256.0f; f32x2 r2; r2.x = __builtin_amdgcn_rcpf(d2.x); r2.y = __builtin_amdgcn_rcpf(d2.y);
                pr[q] = (a2 * u2) * r2; }
            u32x2 o; o.x = pk4_fp8(pr[0].x, pr[0].y, pr[1].x, pr[1].y); o.y = pk4_fp8(pr[2].x, pr[2].y, pr[3].x, pr[3].y); *(u32x2*)(HID + row * FF + col0) = o; }
    }
};
struct EpiDown {
    static constexpr bool PERM = true;
    unsigned char* YS; const float* GATEV;
    __device__ __forceinline__ void operator()(const f32x4 (&acc)[2][2][4][2], const Unit& u, int wr, int wc, int fr, int fq) const {
        const int row0 = u.pm * BM + wr * 64 + fr, col0 = u.pn * BM + wc * 32 + 8 * fq;
#pragma unroll
        EPI_LOOP_ROWS { const size_t row = (size_t)u.grp * (NB * CAP) + row0 + ai * HALF + m * 16; const float gt = GATEV[row] * 0.5f;
#pragma unroll
            for (int bj = 0; bj < 2; ++bj) { const f32x4 v0 = acc[ai][bj][m][0] * gt, v1 = acc[ai][bj][m][1] * gt; u32x2 o; o.x = pk4_fp8(v0[0], v0[1], v0[2], v0[3]); o.y = pk4_fp8(v1[0], v1[1], v1[2], v1[3]); *(u32x2*)(YS + row * 1024 + col0 + bj * HALF) = o; } }
    }
};
}


#define XB_TMO      128
#define XB_XCNT(j)  (256  + 64 * (j))
#define XB_XSUB(j)  (1280 + 64 * (j))
#define XB_XGEN(j)  (2304 + 64 * (j))
#define XB_TOP      3328
#define XB_TOPGEN   3392
#define XCD_BAR_WORDS 3456
#define XB_SPIN_CAP (1u << 20)
__device__ __forceinline__ unsigned xb_ld(unsigned* p)              { return __hip_atomic_load(p, __ATOMIC_RELAXED, __HIP_MEMORY_SCOPE_AGENT); }
__device__ __forceinline__ unsigned xb_add(unsigned* p, unsigned v) { return __hip_atomic_fetch_add(p, v, __ATOMIC_RELAXED, __HIP_MEMORY_SCOPE_AGENT); }
__device__ __forceinline__ unsigned xb_xcc_id() { return (unsigned)__builtin_amdgcn_s_getreg((3 << 11) | 20) & 0xFu; }
#define XB_SPIN(cond, bar) do { unsigned _sp = 0; while (cond) { __builtin_amdgcn_s_sleep(1); \
    if ((++_sp & 255u) == 0u) { if (xb_ld(&(bar)[XB_TMO])) break; if (_sp > XB_SPIN_CAP) { atomicAdd(&(bar)[XB_TMO], 1u); break; } } } } while (0)
struct XcdBarrier { unsigned* bar; unsigned x; volatile LAS unsigned* st; };
__device__ __forceinline__ XcdBarrier xcd_barrier_post(unsigned* bar, volatile LAS unsigned* st) {
    XcdBarrier b; b.bar = bar; b.x = xb_xcc_id(); b.st = st;
    if (threadIdx.x == 0) (void)xb_add(&bar[XB_XCNT(b.x)], 1u);
    return b;
}
__device__ __forceinline__ void xcd_barrier_complete(unsigned* bar, unsigned x, unsigned& nloc, unsigned& nx) {
    const unsigned G = gridDim.x * gridDim.y * gridDim.z;
    unsigned sum, cnt, mine, sp = 0u;
    for (;;) {
        sum = 0u; cnt = 0u; mine = 0u;
#pragma unroll
        for (unsigned j = 0; j < 16; ++j) { const unsigned c = xb_ld(&bar[XB_XCNT(j)]); sum += c; cnt += (c > 0u) ? 1u : 0u; mine = (j == x) ? c : mine; }
        if (sum == G) break;
        __builtin_amdgcn_s_sleep(1);
        if ((++sp & 255u) == 0u) { if (xb_ld(&bar[XB_TMO])) break; if (sp > XB_SPIN_CAP) { atomicAdd(&bar[XB_TMO], 1u); break; } }
    }
    nloc = mine > 0u ? mine : 1u; nx = cnt > 0u ? cnt : 1u;
}
__device__ __forceinline__ void xcd_barrier(const XcdBarrier& b) {
    asm volatile("s_waitcnt vmcnt(0)" ::: "memory");
    __syncthreads();
    if (threadIdx.x == 0) {
        unsigned* bar = b.bar;
        __builtin_amdgcn_s_waitcnt(0);
        unsigned nloc = b.st[0], nx = b.st[1];
        if (nloc == 0u) { xcd_barrier_complete(bar, b.x, nloc, nx); b.st[0] = nloc; b.st[1] = nx; }
        const unsigned old = xb_add(&bar[XB_XSUB(b.x)], 1u);
        const unsigned gen = old / nloc;
        if (old + 1u == (gen + 1u) * nloc) {
            __builtin_amdgcn_fence(__ATOMIC_RELEASE, "agent");
            asm volatile("s_waitcnt vmcnt(0)" ::: "memory");
            const unsigned og = xb_add(&bar[XB_TOP], 1u);
            const unsigned tg = og / nx;
            if (og + 1u == (tg + 1u) * nx) xb_add(&bar[XB_TOPGEN], 1u);
            else XB_SPIN(xb_ld(&bar[XB_TOPGEN]) == tg, bar);
            __builtin_amdgcn_fence(__ATOMIC_ACQUIRE, "agent");
            xb_add(&bar[XB_XGEN(b.x)], 1u);
            asm volatile("s_waitcnt vmcnt(0)" ::: "memory");
        } else {
            XB_SPIN(xb_ld(&bar[XB_XGEN(b.x)]) == gen, bar);
            __builtin_amdgcn_fence(__ATOMIC_ACQUIRE, "agent");
            asm volatile("s_waitcnt vmcnt(0)" ::: "memory");
        }
    }
    __syncthreads();
}

struct Args { const float* in[27]; float* out; unsigned char* ws; int ph_lo, ph_hi; };

struct Frame {
    LAS unsigned char* lds; int tid, lane, wave, G, bid;
    unsigned char* ws; const float* const* in;
};

template <bool F8>
__device__ __forceinline__ void transpose_item(const float* W, int N, void* WTv, int ldt, int k0, int n0, int drow0, float scale, LAS float* scr, int lane, int kd = -1) {
    if (kd < 0) kd = k0;
    float r[64];
#pragma unroll
    for (int i = 0; i < 64; ++i) r[i] = W[(size_t)(k0 + i) * N + n0 + lane];
#pragma unroll
    for (int i = 0; i < 64; ++i) scr[i * 65 + lane] = r[i];
    asm volatile("s_waitcnt lgkmcnt(0)" ::: "memory");
    if (F8) {
        unsigned char* WT = (unsigned char*)WTv;
#pragma unroll
        for (int jj = 0; jj < 4; ++jj) { const int p = lane + 64 * jj, n = p >> 2, c = p & 3; const LAS float* sp = scr + (16 * c) * 65 + n;
            u32x4 o; o.x = pk4_fp8(sp[0] * scale, sp[65] * scale, sp[130] * scale, sp[195] * scale); o.y = pk4_fp8(sp[260] * scale, sp[325] * scale, sp[390] * scale, sp[455] * scale);
            o.z = pk4_fp8(sp[520] * scale, sp[585] * scale, sp[650] * scale, sp[715] * scale); o.w = pk4_fp8(sp[780] * scale, sp[845] * scale, sp[910] * scale, sp[975] * scale);
            *(u32x4*)(WT + (size_t)(drow0 + n) * ldt + kd + 16 * c) = o; }
    } else {
        bf16* WT = (bf16*)WTv;
#pragma unroll
        for (int jj = 0; jj < 8; ++jj) { const int p = lane + 64 * jj, n = p >> 3, c = p & 7; const LAS float* sp = scr + (8 * c) * 65 + n;
            u32x4 o; o.x = pk2(sp[0], sp[65]); o.y = pk2(sp[130], sp[195]); o.z = pk2(sp[260], sp[325]); o.w = pk2(sp[390], sp[455]);
            *(u32x4*)(WT + (size_t)(drow0 + n) * ldt + kd + 8 * c) = o; }
    }
    asm volatile("s_waitcnt lgkmcnt(0)" ::: "memory");
}

__device__ __forceinline__ void p0_s5_tables(const Frame& F) {
    const float* lam_re = F.in[8]; const float* lam_im = F.in[9]; const float* log_dt = F.in[10];
    const float* b_re = F.in[11]; const float* b_im = F.in[12]; const float* c_re = F.in[13]; const float* c_im = F.in[14];
    bf16* BMAIN = (bf16*)(F.ws + WS_BMAIN); bf16* BCO = (bf16*)(F.ws + WS_BCO); float* LT = (float*)(F.ws + WS_LT); float* KT = (float*)(F.ws + WS_KT);
    LAS float* PW = (LAS float*)F.lds;
    LAS float* BB = PW + 2 * 17 * 64 * 2;
    for (int wg = F.bid; wg < 256; wg += F.G) {
        const int g = wg >> 4, sl = wg & 15, tid = F.tid;
        __syncthreads();
        if (tid < 128) {
            const int dir = tid >> 6, p = tid & 63, li = (dir * 16 + g) * 64 + p;
            const float lr = lam_re[li], lim = lam_im[li], dt = expf(log_dt[dir * 16 + g]);
            float l1r, l1i, k_re, k_im;
            {
                const float mag = expf(lr * dt); double rev = (double)lim * (double)dt * 0.15915494309189535; rev -= rint(rev);
                const float ang = (float)(rev * 6.283185307179586), cs = cosf(ang), sn = sinf(ang); l1r = mag * cs; l1i = mag * sn;
                const float sh = sinf(0.5f * ang); const float nr = expm1f(lr * dt) * cs - 2.f * sh * sh, ni = mag * sn;
                const float den = 1.f / (lr * lr + lim * lim); k_re = (nr * lr + ni * lim) * den; k_im = (ni * lr - nr * lim) * den;
            }
            float pr = 1.f, pi = 0.f;
            for (int d = 0; d <= 16; ++d) { PW[((dir * 17 + d) * 64 + p) * 2 + 0] = pr; PW[((dir * 17 + d) * 64 + p) * 2 + 1] = pi; const float nr = pr * l1r - pi * l1i, ni = pr * l1i + pi * l1r; pr = nr; pi = ni; }
            for (int h = 0; h < 16; ++h) { const float br = b_re[li * 16 + h], bi = b_im[li * 16 + h];
                BB[((dir * 64 + p) * 16 + h) * 2 + 0] = k_re * br - k_im * bi; BB[((dir * 64 + p) * 16 + h) * 2 + 1] = k_re * bi + k_im * br; }
            if (sl == 0) {
                const float mag = expf(lr * dt * 16.f); double rev = (double)lim * (double)dt * 16.0 * 0.15915494309189535; rev -= rint(rev);
                const float ang = (float)(rev * 6.283185307179586); LT[li * 2 + 0] = mag * cosf(ang); LT[li * 2 + 1] = mag * sinf(ang); }
        }
        __syncthreads();
        {
            const int dir = tid >> 8, h = (tid >> 4) & 15, hp = tid & 15, d = sl; float s_ = 0.f;
            const float* cr = c_re + ((dir * 16 + g) * 16 + h) * 64; const float* ci = c_im + ((dir * 16 + g) * 16 + h) * 64;
            for (int p = 0; p < 64; ++p) { const float wr_ = PW[((dir * 17 + d) * 64 + p) * 2], wi_ = PW[((dir * 17 + d) * 64 + p) * 2 + 1], br = BB[((dir * 64 + p) * 16 + hp) * 2], bi = BB[((dir * 64 + p) * 16 + hp) * 2 + 1];
                const float zr = wr_ * br - wi_ * bi, zi = wr_ * bi + wi_ * br; s_ += cr[p] * zr - ci[p] * zi; }
            KT[(((g * 2 + dir) * 16 + d) * 16 + h) * 16 + hp] = s_;
        }
        const int i = sl;
        for (int mm = 0; mm < 8; ++mm) {
            const int e = tid + 512 * mm, h = e >> 8, q = e & 255, dir = q >> 7, im = (q >> 6) & 1, p = q & 63, d = dir == 0 ? i + 1 : 16 - i;
            const float cr = c_re[((dir * 16 + g) * 16 + h) * 64 + p], ci = c_im[((dir * 16 + g) * 16 + h) * 64 + p], wr_ = PW[((dir * 17 + d) * 64 + p) * 2], wi_ = PW[((dir * 17 + d) * 64 + p) * 2 + 1];
            BMAIN[((size_t)g * 256 + i * 16 + h) * 512 + 256 + q] = (bf16)f2bf(im ? -(cr * wi_ + ci * wr_) : (cr * wr_ - ci * wi_));
        }
        for (int mm = 0; mm < 8; ++mm) {
            const int e = tid + 512 * mm, ql = e >> 8, k = e & 255, q = sl * 16 + ql, dir = q >> 7, im = (q >> 6) & 1, p = q & 63, j = k >> 4, hp = k & 15, d = dir == 0 ? 15 - j : j;
            const float wr_ = PW[((dir * 17 + d) * 64 + p) * 2], wi_ = PW[((dir * 17 + d) * 64 + p) * 2 + 1], br = BB[((dir * 64 + p) * 16 + hp) * 2], bi = BB[((dir * 64 + p) * 16 + hp) * 2 + 1];
            BCO[((size_t)g * 256 + q) * 256 + k] = (bf16)f2bf(im ? (wr_ * bi + wi_ * br) : (wr_ * br - wi_ * bi));
        }
    }
    __syncthreads();
}
__device__ __forceinline__ void s5_assemble_bmain(const Frame& F) {
    bf16* BMAIN = (bf16*)(F.ws + WS_BMAIN); const float* KT = (const float*)(F.ws + WS_KT); const float* d_skip = F.in[15];
    for (int wg = F.bid; wg < 256; wg += F.G) {
        const int g = wg >> 4, i = wg & 15;
        for (int mm = 0; mm < 8; ++mm) {
            const int e = F.tid + 512 * mm, h = e >> 8, k = e & 255, j = k >> 4, hp = k & 15; float val;
            if (j < i) val = KT[(((g * 2 + 0) * 16 + (i - j)) * 16 + h) * 16 + hp];
            else if (j > i) val = KT[(((g * 2 + 1) * 16 + (j - i)) * 16 + h) * 16 + hp];
            else val = KT[(((g * 2 + 0) * 16 + 0) * 16 + h) * 16 + hp] + KT[(((g * 2 + 1) * 16 + 0) * 16 + h) * 16 + hp] + (h == hp ? d_skip[g * 16 + h] : 0.f);
            BMAIN[((size_t)g * 256 + i * 16 + h) * 512 + k] = (bf16)f2bf(val);
        }
    }
}

__device__ __forceinline__ void p0_weights(const Frame& F) {
    LAS float* scr = (LAS float*)(F.lds + F.wave * 16640);
    const int gw = F.bid * NWAVES + F.wave, NGW = F.G * NWAVES, lane = F.lane;
    bf16* WIN_T = (bf16*)(F.ws + WS_WIN_T); bf16* WUPAB_T = (bf16*)(F.ws + WS_WUPAB_T); bf16* WOUT_T = (bf16*)(F.ws + WS_WOUT_T);
    bf16* WGLU_T = (bf16*)(F.ws + WS_WGLU_T); unsigned char* WG8 = (unsigned char*)(F.ws + WS_WG8); unsigned char* WGU8 = (unsigned char*)(F.ws + WS_WGU_T); unsigned char* WD8 = (unsigned char*)(F.ws + WS_WD_T); bf16* WSB = (bf16*)(F.ws + WS_WS);
    constexpr int I_IN = 16 * 52, I_UA = 8 * 16, I_UB = 4 * 16, I_OUT = 16 * 16, I_GLU = 4 * 4, I_G = 16 * 512, I_D = 16 * 512;
    constexpr int NITEMS = I_IN + I_UA + I_UB + I_OUT + I_GLU + 2 * I_G + I_D;
    for (int it = gw; it < NITEMS; it += NGW) {
        int r = it;
        if (r < I_IN) { const int kb = r / 52, nb = r % 52;
            if (nb < 20) transpose_item<false>(F.in[2], PT, WIN_T, 1024, kb * 64, nb * 64, nb * 64, 1.f, scr, lane);
            else { const int c = nb * 64 - 1280, isb = c >> 10, cc = c & 1023; transpose_item<true>(F.in[2], PT, WG8, 1024, kb * 64, nb * 64, (cc >> 7) * 256 + (cc & 127) + isb * 128, 16.f, scr, lane); }
            continue; } r -= I_IN;
        if (r < I_UA) { const int kb = r / 16, nb = r % 16; transpose_item<false>(F.in[18], 1024, WUPAB_T, 768, kb * 64, nb * 64, nb * 64, 1.f, scr, lane); continue; } r -= I_UA;
        if (r < I_UB) { const int kb = r / 16, nb = r % 16; transpose_item<false>(F.in[19], 1024, WUPAB_T, 768, kb * 64, nb * 64, nb * 64, 1.f, scr, lane, 512 + kb * 64); continue; } r -= I_UB;
        if (r < I_OUT) { const int kb = r / 16, nb = r % 16; transpose_item<false>(F.in[20], 1024, WOUT_T, 1024, kb * 64, nb * 64, nb * 64, 1.f, scr, lane); continue; } r -= I_OUT;
        if (r < I_GLU) { const int kb = r / 4, nb = r % 4; transpose_item<false>(F.in[16], 256, WGLU_T, 256, kb * 64, nb * 64, nb * 64, 1.f, scr, lane); continue; } r -= I_GLU;
        if (r < 2 * I_G) { const int up = r >= I_G ? 1 : 0; if (up) r -= I_G; const int e = r >> 9, w = r & 511, kb = w >> 5, nb = w & 31, n0 = nb * 64;
            transpose_item<true>(F.in[up ? 24 : 23] + (size_t)e * 1024 * 2048, 2048, WGU8 + (size_t)e * 4096 * 1024, 1024, kb * 64, n0, (n0 >> 7) * 256 + (n0 & 127) + up * 128, 16.f, scr, lane); continue; } r -= 2 * I_G;
        { const int e = r >> 9, w = r & 511, kb = w >> 4, nb = w & 15; transpose_item<true>(F.in[25] + (size_t)e * 2048 * 1024, 1024, WD8 + (size_t)e * 1024 * 2048, 2048, kb * 64, nb * 64, nb * 64, 32.f, scr, lane); }
    }
    for (int i = F.bid * NTHR + F.tid; i < 8 * 128 * 128; i += F.G * NTHR) WSB[i] = (bf16)f2bf(F.in[6][i]);
}

__device__ __forceinline__ void rms_row(const float* xrow, const float* g, int lane, f32x4 (&v)[4]) {
    const f32x4* xr = (const f32x4*)xrow + lane; float s = 0.f;
#pragma unroll
    for (int j = 0; j < 4; ++j) { v[j] = xr[64 * j]; s += (v[j].x * v[j].x + v[j].y * v[j].y) + (v[j].z * v[j].z + v[j].w * v[j].w); }
    const float r = 1.f / sqrtf(wave_sum(s) * (1.f / 1024.f) + EPS);
#pragma unroll
    for (int j = 0; j < 4; ++j) { const f32x4 gv = ((const f32x4*)g)[lane + 64 * j]; v[j] = v[j] * r * gv; }
}
__device__ __forceinline__ void store_row_bf16(bf16* orow, int lane, const f32x4 (&v)[4]) {
    u32x2* o8 = (u32x2*)orow + lane;
#pragma unroll
    for (int j = 0; j < 4; ++j) { u32x2 w; w.x = pk2(v[j].x, v[j].y); w.y = pk2(v[j].z, v[j].w); o8[64 * j] = w; }
}

__device__ __forceinline__ void store_row_fp8(unsigned char* orow, int lane, const f32x4 (&v)[4]) {
    unsigned* o4 = (unsigned*)orow + lane;
#pragma unroll
    for (int j = 0; j < 4; ++j) o4[64 * j] = pk4_fp8(v[j].x, v[j].y, v[j].z, v[j].w);
}
template <int R>
__device__ __forceinline__ void load_rows(const float* x0, size_t rstride, int lane, f32x4 (&v)[R][4]) {
#pragma unroll
    for (int r = 0; r < R; ++r)
#pragma unroll
        for (int j = 0; j < 4; ++j) v[r][j] = ((const f32x4*)(x0 + r * rstride))[lane + 64 * j];
}
template <int R>
__device__ __forceinline__ void load_rows_bf16(const bf16* x0, int lane, f32x4 (&v)[R][4]) {
    u32x2 w[R][4];
#pragma unroll
    for (int r = 0; r < R; ++r)
#pragma unroll
        for (int j = 0; j < 4; ++j) w[r][j] = ((const u32x2*)(x0 + (size_t)r * 1024))[lane + 64 * j];
#pragma unroll
    for (int r = 0; r < R; ++r)
#pragma unroll
        for (int j = 0; j < 4; ++j) v[r][j] = (f32x4){bflo(w[r][j].x), bfhi(w[r][j].x), bflo(w[r][j].y), bfhi(w[r][j].y)};
}
template <int R>
__device__ __forceinline__ void load_rows_bf16_raw(const bf16* x0, int lane, u32x2 (&w)[R][4]) {
#pragma unroll
    for (int r = 0; r < R; ++r)
#pragma unroll
        for (int j = 0; j < 4; ++j) w[r][j] = ((const u32x2*)(x0 + (size_t)r * 1024))[lane + 64 * j];
}
template <int R>
__device__ __forceinline__ void rows_from_raw(const u32x2 (&w)[R][4], f32x4 (&v)[R][4]) {
#pragma unroll
    for (int r = 0; r < R; ++r)
#pragma unroll
        for (int j = 0; j < 4; ++j) v[r][j] = (f32x4){bflo(w[r][j].x), bfhi(w[r][j].x), bflo(w[r][j].y), bfhi(w[r][j].y)};
}
template <int R>
__device__ __forceinline__ void rms_scale_rows(const float* g, int lane, f32x4 (&v)[R][4], float* rms_out = nullptr) {
    float s[R];
#pragma unroll
    for (int r = 0; r < R; ++r) { s[r] = 0.f;
#pragma unroll
        for (int j = 0; j < 4; ++j) s[r] += (v[r][j].x * v[r][j].x + v[r][j].y * v[r][j].y) + (v[r][j].z * v[r][j].z + v[r][j].w * v[r][j].w); }
#pragma unroll
    for (int o = 1; o < 64; o <<= 1)
#pragma unroll
        for (int r = 0; r < R; ++r) s[r] += __shfl_xor(s[r], o);
#pragma unroll
    for (int j = 0; j < 4; ++j) { const f32x4 gv = ((const f32x4*)g)[lane + 64 * j];
#pragma unroll
        for (int r = 0; r < R; ++r) { const float rr = 1.f / sqrtf(s[r] * (1.f / 1024.f) + EPS); v[r][j] = v[r][j] * rr * gv; } }
    if (rms_out) {
#pragma unroll
        for (int r = 0; r < R; ++r) if (lane == r) rms_out[r] = sqrtf(s[r] * (1.f / 1024.f) + EPS); }
}
__device__ __forceinline__ void p1_rmsnorm(const Frame& F) {
    const float* x = F.in[0]; const float* g = F.in[1]; bf16* H1 = (bf16*)(F.ws + WS_H1); unsigned char* H1F8 = (unsigned char*)(F.ws + WS_H1F8);
    const int gw = F.bid * NWAVES + F.wave, NGW = F.G * NWAVES;
    f32x4 vn[4][4]; if (gw * 4 < NTOK) load_rows<4>(x + (size_t)(gw * 4) * 1024, 1024, F.lane, vn);
    for (int m = gw * 4; m < NTOK; m += NGW * 4) {
        f32x4 v[4][4];
#pragma unroll
        for (int r = 0; r < 4; ++r)
#pragma unroll
            for (int j = 0; j < 4; ++j) v[r][j] = vn[r][j];
        if (m + NGW * 4 < NTOK) load_rows<4>(x + (size_t)(m + NGW * 4) * 1024, 1024, F.lane, vn);
        rms_scale_rows<4>(g, F.lane, v, (float*)(F.ws + WS_RINV) + m);
#pragma unroll
        for (int r = 0; r < 4; ++r) { store_row_bf16(H1 + (size_t)(m + r) * 1024, F.lane, v[r]); store_row_fp8(H1F8 + (size_t)(m + r) * 1024, F.lane, v[r]); }
    }
}

__device__ __forceinline__ void p3_gmlp(const Frame& F) {
    const bf16* UV = (const bf16*)(F.ws + WS_UV); const bf16* WSB = (const bf16*)(F.ws + WS_WS); bf16* BRA = (bf16*)(F.ws + WS_BRAB);
    const float* ln_g = F.in[4]; const float* ln_b = F.in[5]; const float* b_s = F.in[7];
    LAS unsigned char* vnT = F.lds;
    const int lane = F.lane, w = F.wave;
    f32x4 lg0 = *(const f32x4*)(ln_g + lane * 8), lg1 = *(const f32x4*)(ln_g + lane * 8 + 4), lb0 = *(const f32x4*)(ln_b + lane * 8), lb1 = *(const f32x4*)(ln_b + lane * 8 + 4);
    const float lgv[8] = {lg0.x, lg0.y, lg0.z, lg0.w, lg1.x, lg1.y, lg1.z, lg1.w}, lbv[8] = {lb0.x, lb0.y, lb0.z, lb0.w, lb1.x, lb1.y, lb1.z, lb1.w};
    for (int chunk = F.bid; chunk < NTOK / 128; chunk += F.G) {
        const size_t tok0 = (size_t)chunk * 128;
        __syncthreads();
#pragma unroll 1
        for (int hf = 0; hf < 2; ++hf) {
            u32x4 raw[8];
#pragma unroll
            for (int tt = 0; tt < 8; ++tt) raw[tt] = *(const u32x4*)(UV + (tok0 + w * 16 + hf * 8 + tt) * 1024 + 512 + lane * 8);
            float mean[8], rstd[8];
#pragma unroll
            for (int tt = 0; tt < 8; ++tt) { const u32x4 r = raw[tt]; mean[tt] = ((bflo(r.x) + bfhi(r.x)) + (bflo(r.y) + bfhi(r.y))) + ((bflo(r.z) + bfhi(r.z)) + (bflo(r.w) + bfhi(r.w))); }
#pragma unroll
            for (int o = 1; o < 64; o <<= 1)
#pragma unroll
                for (int tt = 0; tt < 8; ++tt) mean[tt] += __shfl_xor(mean[tt], o);
#pragma unroll
            for (int tt = 0; tt < 8; ++tt) { mean[tt] *= (1.f / 512.f); const u32x4 r = raw[tt]; const float m_ = mean[tt];
                const float d0 = bflo(r.x) - m_, d1 = bfhi(r.x) - m_, d2 = bflo(r.y) - m_, d3 = bfhi(r.y) - m_, d4 = bflo(r.z) - m_, d5 = bfhi(r.z) - m_, d6 = bflo(r.w) - m_, d7 = bfhi(r.w) - m_;
                rstd[tt] = ((d0 * d0 + d1 * d1) + (d2 * d2 + d3 * d3)) + ((d4 * d4 + d5 * d5) + (d6 * d6 + d7 * d7)); }
#pragma unroll
            for (int o = 1; o < 64; o <<= 1)
#pragma unroll
                for (int tt = 0; tt < 8; ++tt) rstd[tt] += __shfl_xor(rstd[tt], o);
#pragma unroll
            for (int tt = 0; tt < 8; ++tt) rstd[tt] = 1.f / sqrtf(rstd[tt] * (1.f / 512.f) + EPS);
#pragma unroll
            for (int e = 0; e < 8; ++e) {
                unsigned pk[4];
#pragma unroll
                for (int t2 = 0; t2 < 4; ++t2) {
                    const unsigned wa = (e >> 1) == 0 ? raw[2 * t2].x : (e >> 1) == 1 ? raw[2 * t2].y : (e >> 1) == 2 ? raw[2 * t2].z : raw[2 * t2].w;
                    const unsigned wb = (e >> 1) == 0 ? raw[2 * t2 + 1].x : (e >> 1) == 1 ? raw[2 * t2 + 1].y : (e >> 1) == 2 ? raw[2 * t2 + 1].z : raw[2 * t2 + 1].w;
                    const float fa = (e & 1) ? bfhi(wa) : bflo(wa), fb = (e & 1) ? bfhi(wb) : bflo(wb);
                    pk[t2] = pk2((fa - mean[2 * t2]) * rstd[2 * t2] * lgv[e] + lbv[e], (fb - mean[2 * t2 + 1]) * rstd[2 * t2 + 1] * lgv[e] + lbv[e]); }
                *(LAS u32x4*)(vnT + (lane * 8 + e) * 272 + w * 32 + hf * 16) = (u32x4){pk[0], pk[1], pk[2], pk[3]}; }
        }
        __syncthreads();
        const int t = w * 16 + (lane & 15), kq = (lane >> 4) * 8, t2 = lane >> 2, part = lane & 3;
        bf16x8 wf[4];
#pragma unroll
        for (int kk = 0; kk < 4; ++kk) wf[kk] = *(const bf16x8*)(WSB + ((size_t)0 * 128 + t) * 128 + kk * 32 + kq);
#pragma unroll
        for (int g = 0; g < 8; ++g) {
            bf16x8 wn[4];
            const bf16* up = UV + (tok0 + w * 16 + t2) * 1024 + g * 64 + part * 16;
            const u32x4 ua = *(const u32x4*)up, ub = *(const u32x4*)(up + 8);
            if (g < 7) {
#pragma unroll
                for (int kk = 0; kk < 4; ++kk) wn[kk] = *(const bf16x8*)(WSB + ((size_t)(g + 1) * 128 + t) * 128 + kk * 32 + kq); }
            const float bs = b_s[g * 128 + t];
            f32x4 acc[4];
#pragma unroll
            for (int ct = 0; ct < 4; ++ct) acc[ct] = (f32x4){0.f, 0.f, 0.f, 0.f};
#pragma unroll
            for (int kk = 0; kk < 4; ++kk)
#pragma unroll
                for (int ct = 0; ct < 4; ++ct) { const bf16x8 vf = *(const LAS bf16x8*)(vnT + (g * 64 + ct * 16 + (lane & 15)) * 272 + (kk * 32 + kq) * 2);
                    acc[ct] = __builtin_amdgcn_mfma_f32_16x16x32_bf16(vf, wf[kk], acc[ct], 0, 0, 0); }
            __syncthreads();
            LAS unsigned char* stg = vnT + g * 64 * 272 + w * 2176;
#pragma unroll
            for (int ct = 0; ct < 4; ++ct) { u32x2 zz; zz.x = pk2(acc[ct][0] + bs, acc[ct][1] + bs); zz.y = pk2(acc[ct][2] + bs, acc[ct][3] + bs);
                *(LAS u32x2*)(stg + (lane & 15) * 136 + ct * 32 + (lane >> 4) * 8) = zz; }
            u32x2 zr[4];
#pragma unroll
            for (int k = 0; k < 4; ++k) zr[k] = *(const LAS u32x2*)(stg + t2 * 136 + part * 32 + k * 8);
            u32x4 oa, ob;
            oa.x = pk2(bflo(ua.x) * bflo(zr[0].x), bfhi(ua.x) * bfhi(zr[0].x)); oa.y = pk2(bflo(ua.y) * bflo(zr[0].y), bfhi(ua.y) * bfhi(zr[0].y));
            oa.z = pk2(bflo(ua.z) * bflo(zr[1].x), bfhi(ua.z) * bfhi(zr[1].x)); oa.w = pk2(bflo(ua.w) * bflo(zr[1].y), bfhi(ua.w) * bfhi(zr[1].y));
            ob.x = pk2(bflo(ub.x) * bflo(zr[2].x), bfhi(ub.x) * bfhi(zr[2].x)); ob.y = pk2(bflo(ub.y) * bflo(zr[2].y), bfhi(ub.y) * bfhi(zr[2].y));
            ob.z = pk2(bflo(ub.z) * bflo(zr[3].x), bfhi(ub.z) * bfhi(zr[3].x)); ob.w = pk2(bflo(ub.w) * bflo(zr[3].y), bfhi(ub.w) * bfhi(zr[3].y));
            bf16* op = BRA + (tok0 + w * 16 + t2) * 768 + g * 64 + part * 16;
            *(u32x4*)op = oa; *(u32x4*)(op + 8) = ob;
            if (g < 7) {
#pragma unroll
                for (int kk = 0; kk < 4; ++kk) wf[kk] = wn[kk]; }
            asm volatile("" ::: "memory");
        }
    }
}

__device__ __forceinline__ void p4_scan(const Frame& F) {
    const float* SLOC = (const float*)(F.ws + WS_SLOC); bf16* ACOMB = (bf16*)(F.ws + WS_ACOMB); const float* LT = (const float*)(F.ws + WS_LT);
    if (F.tid >= 128) return;
    for (int wg = F.bid; wg < 256; wg += F.G) {
        const int b = wg >> 4, g = wg & 15, dir = F.tid >> 6, p = F.tid & 63;
        const float lr = LT[((dir * 16 + g) * 64 + p) * 2], li = LT[((dir * 16 + g) * 64 + p) * 2 + 1];
        float xr = 0.f, xi = 0.f;
        const size_t rowbase = (size_t)g * NCHUNK + (size_t)b * CPS;
        for (int c0 = 0; c0 < CPS; c0 += 16) {
            float sr[16], si[16];
#pragma unroll
            for (int k = 0; k < 16; ++k) { const int c = dir ? (CPS - 1 - (c0 + k)) : (c0 + k); const float* sp = SLOC + (rowbase + c) * 256 + dir * 128 + p; sr[k] = sp[0]; si[k] = sp[64]; }
#pragma unroll
            for (int k = 0; k < 16; ++k) { const int c = dir ? (CPS - 1 - (c0 + k)) : (c0 + k); bf16* op = ACOMB + (rowbase + c) * 512 + 256 + dir * 128 + p;
                op[0] = (bf16)f2bf(xr); op[64] = (bf16)f2bf(xi);
                const float nr = lr * xr - li * xi + sr[k], ni = lr * xi + li * xr + si[k]; xr = nr; xi = ni; }
        }
    }
}

__device__ __forceinline__ void p9_norm_router(const Frame& F, const bf16* X1) {
    const float* g2 = F.in[21]; const float* wrt = F.in[22]; unsigned char* H2 = (unsigned char*)(F.ws + WS_H2); float* PROBS = (float*)(F.ws + WS_PROBS);
    LAS unsigned char* WH = F.lds; LAS unsigned char* WL = F.lds + 32768;
    __syncthreads();
    for (int i = F.tid; i < 2048; i += NTHR) { const int kk = i >> 6, l = i & 63, n = l & 15, k0 = kk * 32 + (l >> 4) * 8;
        u32x4 hi, lo;
#pragma unroll
        for (int p = 0; p < 4; ++p) { const float w0 = g2[k0 + 2 * p] * wrt[(k0 + 2 * p) * 16 + n], w1 = g2[k0 + 2 * p + 1] * wrt[(k0 + 2 * p + 1) * 16 + n];
            const unsigned h = cvt_pk_bf16(w0, w1), lw = cvt_pk_bf16(w0 - bflo(h), w1 - bfhi(h));
            if (p == 0) { hi.x = h; lo.x = lw; } else if (p == 1) { hi.y = h; lo.y = lw; } else if (p == 2) { hi.z = h; lo.z = lw; } else { hi.w = h; lo.w = lw; } }
        *(LAS u32x4*)(WH + i * 16) = hi; *(LAS u32x4*)(WL + i * 16) = lo; }
    __syncthreads();
    const int gw = F.bid * NWAVES + F.wave, NGW = F.G * NWAVES, lane = F.lane, fr = lane & 15, fq = lane >> 4;
    for (int blk = gw; blk < NTOK / 16; blk += NGW) {
        const int m0 = NTOK - 16 - blk * 16;
        float rrl = 0.f;
        u32x2 wnx[2][4]; load_rows_bf16_raw<2>(X1 + (size_t)m0 * 1024, lane, wnx);
#pragma unroll 1
        for (int s2 = 0; s2 < 8; ++s2) {
            f32x4 v[2][4]; rows_from_raw<2>(wnx, v);
            if (s2 < 7) load_rows_bf16_raw<2>(X1 + (size_t)(m0 + 2 * s2 + 2) * 1024, lane, wnx);
            float ss[2];
#pragma unroll
            for (int r = 0; r < 2; ++r) { ss[r] = 0.f;
#pragma unroll
                for (int j = 0; j < 4; ++j) ss[r] += (v[r][j].x * v[r][j].x + v[r][j].y * v[r][j].y) + (v[r][j].z * v[r][j].z + v[r][j].w * v[r][j].w); }
#pragma unroll
            for (int o = 1; o < 64; o <<= 1)
#pragma unroll
                for (int r = 0; r < 2; ++r) ss[r] += __shfl_xor(ss[r], o);
#pragma unroll
            for (int r = 0; r < 2; ++r) { const float rr = 1.f / sqrtf(ss[r] * (1.f / 1024.f) + EPS); if (fr == 2 * s2 + r) rrl = rr;
#pragma unroll
                for (int j = 0; j < 4; ++j) { const f32x4 gv = ((const f32x4*)g2)[lane + 64 * j]; v[r][j] = v[r][j] * rr * gv; }
                store_row_fp8(H2 + (size_t)(m0 + 2 * s2 + r) * 1024, lane, v[r]); }
        }
        f32x4 acc = (f32x4){0.f, 0.f, 0.f, 0.f};
        const bf16* xr = X1 + (size_t)(m0 + fr) * 1024 + fq * 8;
#pragma unroll 1
        for (int c = 0; c < 4; ++c) {
            bf16x8 xa[8];
#pragma unroll
            for (int i = 0; i < 8; ++i) xa[i] = *(const bf16x8*)(xr + (c * 8 + i) * 32);
#pragma unroll
            for (int i = 0; i < 8; ++i) { const int kk = c * 8 + i; const bf16x8 wh = *(const LAS bf16x8*)(WH + (kk * 64 + lane) * 16), wl = *(const LAS bf16x8*)(WL + (kk * 64 + lane) * 16);
                acc = __builtin_amdgcn_mfma_f32_16x16x32_bf16(wh, xa[i], acc, 0, 0, 0); acc = __builtin_amdgcn_mfma_f32_16x16x32_bf16(wl, xa[i], acc, 0, 0, 0); }
        }
        const f32x4 lg = acc * rrl;
        float mx = fmaxf(fmaxf(lg[0], lg[1]), fmaxf(lg[2], lg[3])); mx = fmaxf(mx, __shfl_xor(mx, 16)); mx = fmaxf(mx, __shfl_xor(mx, 32));
        float ex[4], den = 0.f;
#pragma unroll
        for (int j = 0; j < 4; ++j) { ex[j] = expf(lg[j] - mx); den += ex[j]; }
        den += __shfl_xor(den, 16); den += __shfl_xor(den, 32);
        const int mm = m0 + fr; const float inv = 1.f / den;
#pragma unroll
        for (int j = 0; j < 4; ++j) PROBS[((size_t)(mm >> 12) * 16 + 4 * fq + j) * SEQ + (mm & (SEQ - 1))] = ex[j] * inv;
    }
}

__device__ __forceinline__ int block_excl_scan(int v, LAS int* tmp, int tid, int lane, int wave, int& total) {
    int inc = v;
#pragma unroll
    for (int o = 1; o < 64; o <<= 1) { const int t = __shfl_up(inc, o); if (lane >= o) inc += t; }
    __syncthreads();
    if (lane == 63) tmp[wave] = inc;
    __syncthreads();
    int base = 0, tot = 0;
#pragma unroll
    for (int w = 0; w < 8; ++w) { const int t = tmp[w]; tot += t; if (w < wave) base += t; }
    total = tot; return base + inc - v;
}
__device__ __forceinline__ void p10_topk(const Frame& F) {
    const float* PROBS = (const float*)(F.ws + WS_PROBS); float* GATEV = (float*)(F.ws + WS_GATEV); int* SEL = (int*)(F.ws + WS_SEL);
    LAS int* red = (LAS int*)F.lds;
    int* TOKS = (int*)(F.ws + WS_TOKS);
    const int tid = F.tid, lane = F.lane, wave = F.wave;
    for (int pair = F.bid; pair < 256; pair += F.G) {
        const int e = pair >> 4, b = pair & 15;
        const float* src = PROBS + ((size_t)b * 16 + e) * SEQ + tid * 8;
        const f32x4 p0 = *(const f32x4*)src, p1 = *(const f32x4*)(src + 4);
        float vals[8] = {p0.x, p0.y, p0.z, p0.w, p1.x, p1.y, p1.z, p1.w};
        unsigned key[8];
#pragma unroll
        for (int i = 0; i < 8; ++i) key[i] = __builtin_bit_cast(unsigned, vals[i]);
        unsigned tau = 0u;
        __syncthreads();
        for (int bit = 29, rnd = 0; bit >= -1; bit -= 2, ++rnd) {
            const int sh = bit < 0 ? 0 : bit; const unsigned step = 1u << sh;
            const unsigned c1 = tau + step, c2 = bit < 0 ? c1 : tau + 2 * step, c3 = bit < 0 ? c1 : tau + 3 * step;
            int n1 = 0, n2 = 0, n3 = 0;
#pragma unroll
            for (int i = 0; i < 8; ++i) { n1 += __popcll(__ballot(key[i] >= c1)); n2 += __popcll(__ballot(key[i] >= c2)); n3 += __popcll(__ballot(key[i] >= c3)); }
            LAS int* r = red + (rnd & 1) * 32;
            if (lane == 0) { r[wave] = n1; r[8 + wave] = n2; r[16 + wave] = n3; }
            __syncthreads();
            int t1 = 0, t2 = 0, t3 = 0;
#pragma unroll
            for (int w = 0; w < 8; ++w) { t1 += r[w]; t2 += r[8 + w]; t3 += r[16 + w]; }
            if (t3 >= CAP) tau = c3; else if (t2 >= CAP) tau = c2; else if (t1 >= CAP) tau = c1;
        }
        int gtc = 0, eqc = 0;
#pragma unroll
        for (int i = 0; i < 8; ++i) { gtc += key[i] > tau ? 1 : 0; eqc += key[i] == tau ? 1 : 0; }
        int n_gt, n_eq;
        (void)block_excl_scan(gtc, red + 64, tid, lane, wave, n_gt);
        const int eq_before = block_excl_scan(eqc, red + 64, tid, lane, wave, n_eq);
        const int need_eq = CAP - n_gt;
        int selc = 0, er = eq_before; bool sel[8];
#pragma unroll
        for (int i = 0; i < 8; ++i) { bool s = key[i] > tau; if (key[i] == tau) { s = er < need_eq; ++er; } sel[i] = s; selc += s ? 1 : 0; }
        int n_sel; int slot = block_excl_scan(selc, red + 64, tid, lane, wave, n_sel);
#pragma unroll
        for (int i = 0; i < 8; ++i) { const int l = tid * 8 + i, tok = b * SEQ + l;
            if (sel[i]) { TOKS[(e * NB + b) * CAP + slot] = tok; GATEV[(e * NB + b) * CAP + slot] = vals[i]; SEL[(size_t)tok * 16 + e] = slot; ++slot; }
            else SEL[(size_t)tok * 16 + e] = -1; }
    }
}

__device__ __forceinline__ void p13_final(const Frame& F, const bf16* X1, float* OUT) {
    const float* fg = F.in[26]; const unsigned char* YS = (const unsigned char*)(F.ws + WS_YS); const int* SEL = (const int*)(F.ws + WS_SEL);
    const int gw = F.bid * NWAVES + F.wave, NGW = F.G * NWAVES, lane = F.lane;
    u32x2 wnx[2][4]; int slotn[2] = {-1, -1};
    if (gw * 2 < NTOK) { load_rows_bf16_raw<2>(X1 + (size_t)(gw * 2) * 1024, lane, wnx);
#pragma unroll
        for (int r = 0; r < 2; ++r) slotn[r] = (lane < 16) ? SEL[(size_t)(gw * 2 + r) * 16 + lane] : -1; }
    for (int m = gw * 2; m < NTOK; m += NGW * 2) {
        f32x4 v[2][4]; int myslot[2] = {slotn[0], slotn[1]};
        rows_from_raw<2>(wnx, v);
        if (m + NGW * 2 < NTOK) { load_rows_bf16_raw<2>(X1 + (size_t)(m + NGW * 2) * 1024, lane, wnx);
#pragma unroll
            for (int r = 0; r < 2; ++r) slotn[r] = (lane < 16) ? SEL[(size_t)(m + NGW * 2 + r) * 16 + lane] : -1; }
        const int b = m >> 12;
#pragma unroll
        for (int r = 0; r < 2; ++r) {
            unsigned long long mask = __ballot(myslot[r] >= 0);
            while (mask) {
                unsigned w4[4][4]; int ne = 0;
#pragma unroll
                for (int q = 0; q < 4; ++q) { if (mask) { const int e = __builtin_ctzll(mask); mask &= mask - 1; const int sl = __shfl(myslot[r], e);
                        const unsigned* yr = (const unsigned*)(YS + ((size_t)e * (NB * CAP) + b * CAP + sl) * 1024);
#pragma unroll
                        for (int j = 0; j < 4; ++j) w4[q][j] = yr[lane + 64 * j]; ne = q + 1; } }
#pragma unroll
                for (int q = 0; q < 4; ++q) { if (q < ne) {
#pragma unroll
                        for (int j = 0; j < 4; ++j) { const f32x2 lo = __builtin_amdgcn_cvt_pk_f32_fp8(w4[q][j], false), hi = __builtin_amdgcn_cvt_pk_f32_fp8(w4[q][j], true);
                            v[r][j].x += lo.x * 0.0625f; v[r][j].y += lo.y * 0.0625f; v[r][j].z += hi.x * 0.0625f; v[r][j].w += hi.y * 0.0625f; } } }
            }
        }
        rms_scale_rows<2>(fg, lane, v);
#pragma unroll
        for (int r = 0; r < 2; ++r)
#pragma unroll
            for (int j = 0; j < 4; ++j) ((f32x4*)(OUT + (size_t)(m + r) * 1024))[lane + 64 * j] = v[r][j];
    }
}

constexpr int NPHASE = 13;
__global__ void __launch_bounds__(NTHR, 2) fwd_kernel(Args args) {
    extern __shared__ __attribute__((aligned(16))) unsigned char lds_raw[];
    Frame F; F.lds = (LAS unsigned char*)lds_raw; F.tid = threadIdx.x; F.lane = F.tid & 63; F.wave = __builtin_amdgcn_readfirstlane(F.tid >> 6);
    F.G = gridDim.x; F.bid = blockIdx.x; F.ws = args.ws; F.in = args.in;
    const int lo = args.ph_lo, hi = args.ph_hi;
    volatile LAS unsigned* bst = (volatile LAS unsigned*)(F.lds + LDS_BYTES - 64);
    if (F.tid < 2) bst[F.tid] = 0u;
    __syncthreads();
    XcdBarrier bar; bar.bar = (unsigned*)args.ws; bar.x = 0; bar.st = bst;
    if (hi - lo > 1) bar = xcd_barrier_post((unsigned*)args.ws, bst);
    unsigned char* ws = args.ws; bf16* X1 = (bf16*)(ws + WS_X1B);
#define IN(k) (lo <= (k) && (k) < hi)
#define SEAM(k) do { if (IN(k) && IN((k) + 1)) { xcd_barrier(bar); } } while (0)
    using namespace pg8;
    if (IN(0)) { p0_s5_tables(F); p0_weights(F); p1_rmsnorm(F); }
    SEAM(0);
    if (IN(1)) {
        { DenseSched S; S.T.init(NTOK / 256, 5, 1, F.G, F.bid); S.T.rev = 1; S.A = (const char*)(ws + WS_H1); S.B = (const char*)(ws + WS_WIN_T); S.a_grp = 0; S.b_grp = 0; S.lda = 2048; S.K = 2048;
          EpiWin E{(bf16*)(ws + WS_UV), (bf16*)(ws + WS_ACOMB)}; gemm_phase(F.lds, S, E); } }
    SEAM(1);
    if (IN(2)) { s5_assemble_bmain(F); p3_gmlp(F); __syncthreads();
        DenseSched S; S.T.init(NCHUNK / 256, 1, 16, F.G, F.bid); S.A = (const char*)(ws + WS_ACOMB); S.B = (const char*)(ws + WS_BCO); S.a_grp = (size_t)NCHUNK * 512 * 2; S.b_grp = (size_t)256 * 256 * 2; S.lda = 1024; S.K = 512;
        EpiCarry E{(float*)(ws + WS_SLOC)}; gemm_phase(F.lds, S, E); }
    SEAM(2);
    if (IN(3)) { p4_scan(F); }
    SEAM(3);
    if (IN(4)) { DenseSched S; S.T.init(NCHUNK / 256, 1, 16, F.G, F.bid); S.A = (const char*)(ws + WS_ACOMB); S.B = (const char*)(ws + WS_BMAIN); S.a_grp = (size_t)NCHUNK * 512 * 2; S.b_grp = (size_t)256 * 512 * 2; S.lda = 1024; S.K = 1024;
        EpiS5 E{(bf16*)(ws + WS_Y)}; gemm_phase(F.lds, S, E); }
    SEAM(4);
    if (IN(5)) { DenseSched S; S.T.init(NTOK / 256, 1, 1, F.G, F.bid); S.A = (const char*)(ws + WS_Y); S.B = (const char*)(ws + WS_WGLU_T); S.a_grp = 0; S.b_grp = 0; S.lda = 512; S.K = 512;
        EpiGlu E{(const bf16*)(ws + WS_Y), (bf16*)(ws + WS_BRAB), args.in[17]}; gemm_phase(F.lds, S, E);
        { DenseSched S; S.T.init(NTOK / 256, 8, 1, F.G, F.bid); S.A = (const char*)(ws + WS_H1F8); S.B = (const char*)(ws + WS_WG8); S.a_grp = 0; S.b_grp = 0; S.lda = 1024; S.K = 1024;
          EpiGate E{(bf16*)(ws + WS_GATES), args.in[3]}; gemm_phase<EpiGate, DenseSched, true>(F.lds, S, E); } }
    SEAM(5);
    if (IN(6)) {
        DenseSched S; S.T.init(NTOK / 256, 4, 1, F.G, F.bid); S.T.rev = 1; S.A = (const char*)(ws + WS_BRAB); S.B = (const char*)(ws + WS_WUPAB_T); S.a_grp = 0; S.b_grp = 0; S.lda = 1536; S.K = 1536;
        EpiMerged E{(bf16*)(ws + WS_MERGED), (const bf16*)(ws + WS_GATES)}; gemm_phase(F.lds, S, E); }
    SEAM(6);
    if (IN(7)) { DenseSched S; S.T.init(NTOK / 256, 4, 1, F.G, F.bid); S.A = (const char*)(ws + WS_MERGED); S.B = (const char*)(ws + WS_WOUT_T); S.a_grp = 0; S.b_grp = 0; S.lda = 2048; S.K = 2048;
        EpiOut E{(const bf16*)(ws + WS_H1), (const float*)(ws + WS_RINV), args.in[1], X1}; gemm_phase(F.lds, S, E); }
    SEAM(7);
    if (IN(8)) { p9_norm_router(F, X1); }
    SEAM(8);
    if (IN(9)) { p10_topk(F); }
    SEAM(9);
    if (IN(10)) { GatherSched S; S.T.init((NB * CAP) / 256, (2 * FF) / 256, NE, F.G, F.bid); S.A = (const char*)(ws + WS_H2); S.B = (const char*)(ws + WS_WGU_T); S.toks = (const int*)(ws + WS_TOKS);
        S.rows_grp = NB * CAP; S.b_grp = (size_t)4096 * 1024; S.lda = 1024; S.K = 1024;
        EpiHid E{(unsigned char*)(ws + WS_HID)}; gemm_phase<EpiHid, GatherSched, true>(F.lds, S, E); }
    SEAM(10);
    if (IN(11)) { DenseSched S; S.T.init((NB * CAP) / 256, DM / 256, NE, F.G, F.bid); S.A = (const char*)(ws + WS_HID); S.B = (const char*)(ws + WS_WD_T); S.a_grp = (size_t)(NB * CAP) * FF; S.b_grp = (size_t)DM * FF; S.lda = FF; S.K = FF;
        EpiDown E{(unsigned char*)(ws + WS_YS), (const float*)(ws + WS_GATEV)}; gemm_phase<EpiDown, DenseSched, true>(F.lds, S, E); }
    SEAM(11);
    if (IN(12)) { p13_final(F, X1, args.out); }
#undef IN
#undef SEAM
}


extern "C" void kernel_launch(void* const* d_in, const int* in_sizes, int n_in, void* d_out, int out_size, void* d_ws, size_t ws_size, hipStream_t stream) {
    static int grid = 0;
    if (grid == 0) {
        if (n_in != 27 || out_size != NTOK * DM || ws_size < WS_END) { fprintf(stderr, "kernel_launch: unexpected shapes: n_in %d out %d ws %zu (need >= %zu)\n", n_in, out_size, ws_size, (size_t)WS_END); grid = -1; return; }
        int dev = 0, cus = 0, per_cu = 0;
        if (hipGetDevice(&dev) != hipSuccess || hipDeviceGetAttribute(&cus, hipDeviceAttributeMultiprocessorCount, dev) != hipSuccess) { grid = -1; return; }
        if (hipFuncSetAttribute((const void*)fwd_kernel, hipFuncAttributeMaxDynamicSharedMemorySize, LDS_BYTES) != hipSuccess) { fprintf(stderr, "kernel_launch: hipFuncSetAttribute failed\n"); grid = -1; return; }
        if (hipOccupancyMaxActiveBlocksPerMultiprocessor(&per_cu, (const void*)fwd_kernel, NTHR, LDS_BYTES) != hipSuccess || per_cu < 1) { fprintf(stderr, "kernel_launch: occupancy query says %d\n", per_cu); per_cu = 1; }
        (void)hipGetLastError();
        grid = cus;
    }
    if (grid < 0) return;
    Args a{};
    for (int i = 0; i < 27; ++i) a.in[i] = (const float*)d_in[i];
    a.out = (float*)d_out; a.ws = (unsigned char*)d_ws;
#if MK_ONE_LAUNCH
    a.ph_lo = 0; a.ph_hi = NPHASE;
    (void)hipMemsetAsync(d_ws, 0, 16384, stream);
    hipLaunchKernelGGL(fwd_kernel, dim3(grid), dim3(NTHR), LDS_BYTES, stream, a);
#else
    for (int p = 0; p < NPHASE; ++p) { a.ph_lo = p; a.ph_hi = p + 1; hipLaunchKernelGGL(fwd_kernel, dim3(grid), dim3(NTHR), LDS_BYTES, stream, a); }
#endif
}
```
